# Optimizing an MI355X kernel written in HIP

```python
import jax
import jax.numpy as jnp
from jax import lax
import numpy as np

D_MODEL = 1024
BATCH = 2
SEQ = 8192
DEPTH = 2

CTX_LEN = 256
GRID_W = 64
HEAD_DIM = 64
D_MIX = D_MODEL
GROUP_W = D_MIX // 4
Q_BLOCK = 128
ROPE_THETA = 10000.0
NORM_EPS = 1e-6
D_FF = 2816

MLA_HEADS = 4
MLA_Q_RANK = 256
MLA_KV_RANK = 128
MLA_NOPE = 64
MLA_ROPE = 32
MLA_V = 64
RWKV_HEADS = 4
RWKV_N = 64
RWKV_W_LORA = 32
RWKV_A_LORA = 32
RWKV_G_LORA = 64
RWKV_LNX_EPS = 64e-5
NA_HEADS = 4
NA_WIN_R = 8
NA_WIN_C = 16
GQA_Q_HEADS = 4
GQA_KV_HEADS = 2

MLA_COLS = MLA_Q_RANK + MLA_KV_RANK + MLA_ROPE
RWKV_COLS = 3 * GROUP_W + 2 * RWKV_W_LORA + 2 * RWKV_A_LORA + RWKV_G_LORA
NA_COLS = 3 * GROUP_W
GQA_COLS = (GQA_Q_HEADS + 2 * GQA_KV_HEADS) * HEAD_DIM
N_IN_COLS = MLA_COLS + RWKV_COLS + NA_COLS + GQA_COLS
MIX_SPLITS = [MLA_COLS, MLA_COLS + RWKV_COLS, MLA_COLS + RWKV_COLS + NA_COLS]
RWKV_SPLITS = [GROUP_W, 2 * GROUP_W, 3 * GROUP_W,
               3 * GROUP_W + RWKV_W_LORA, 3 * GROUP_W + 2 * RWKV_W_LORA,
               3 * GROUP_W + 2 * RWKV_W_LORA + RWKV_A_LORA,
               3 * GROUP_W + 2 * RWKV_W_LORA + 2 * RWKV_A_LORA]

kernel_name = 'hybrid_parallel_group_diffusion_trunk'


def rms_norm(x, gain):
    xf = x.astype(jnp.float32)
    y = xf * lax.rsqrt(jnp.mean(xf * xf, axis=-1, keepdims=True) + NORM_EPS)
    return (y * gain.astype(jnp.float32)).astype(x.dtype)


def modulate(x, shift, scale):
    return x * (1 + scale) + shift


def swiglu(h, w_gu, w_down):
    gate, up = jnp.split(h @ w_gu, 2, axis=-1)
    return (jax.nn.silu(gate) * up) @ w_down


def rope_axis(x, pos):
    half = x.shape[-1] // 2
    inv_freq = ROPE_THETA ** (-jnp.arange(half, dtype=jnp.float32) / half)
    ang = pos.astype(jnp.float32)[:, None] * inv_freq[None, :]
    cos = jnp.cos(ang)[:, None, :].astype(x.dtype)
    sin = jnp.sin(ang)[:, None, :].astype(x.dtype)
    x1, x2 = x[..., :half], x[..., half:]
    return jnp.concatenate([x1 * cos - x2 * sin, x1 * sin + x2 * cos], axis=-1)


def rope_2d(x, row, col):
    a = x.shape[-1] // 2
    return jnp.concatenate([rope_axis(x[..., :a], row), rope_axis(x[..., a:], col)], axis=-1)


def blocked_attention(q, k, v, scale):
    B, S, H, dq = q.shape
    Hk, dv = k.shape[2], v.shape[-1]
    G = H // Hk
    nb = S // Q_BLOCK
    qb = q.reshape(B, nb, Q_BLOCK, Hk, G, dq).transpose(1, 0, 2, 3, 4, 5)

    def one_block(q_blk):
        s = jnp.einsum('bqkgd,btkd->bkgqt', q_blk, k, preferred_element_type=jnp.float32) * scale
        p = jax.nn.softmax(s, axis=-1).astype(v.dtype)
        return jnp.einsum('bkgqt,btkd->bqkgd', p, v)

    o = lax.map(one_block, qb)
    return o.transpose(1, 0, 2, 3, 4, 5).reshape(B, S, H, dv)


def neighbourhood_attention(q, k, v, k_ctx, v_ctx, rpb, scale):
    B, S, H, dh = q.shape
    rows = S // GRID_W
    win_r = min(NA_WIN_R, rows)
    n_nb = win_r * NA_WIN_C
    qg = q.reshape(B, rows, GRID_W, H, dh).transpose(1, 0, 2, 3, 4)
    kg = k.reshape(B, rows, GRID_W, H, dh)
    vg = v.reshape(B, rows, GRID_W, H, dh)
    cols = jnp.arange(GRID_W)
    c0 = jnp.clip(cols - NA_WIN_C // 2, 0, GRID_W - NA_WIN_C)
    col_idx = c0[:, None] + jnp.arange(NA_WIN_C)[None, :]
    dc_idx = col_idx - cols[:, None] + NA_WIN_C - 1

    def one_row(args):
        r, q_row = args
        r0 = jnp.clip(r - win_r // 2, 0, rows - win_r)
        k_nb = lax.dynamic_slice_in_dim(kg, r0, win_r, axis=1)[:, :, col_idx]
        v_nb = lax.dynamic_slice_in_dim(vg, r0, win_r, axis=1)[:, :, col_idx]
        dr_idx = r0 + jnp.arange(win_r) - r + NA_WIN_R - 1
        bias = rpb[:, dr_idx[:, None, None], dc_idx[None, :, :]].transpose(0, 2, 1, 3)
        s_nb = jnp.einsum('bchd,bicjhd->bhcij', q_row, k_nb,
                          preferred_element_type=jnp.float32) * scale + bias.astype(jnp.float32)
        s_ctx = jnp.einsum('bchd,blhd->bhcl', q_row, k_ctx, preferred_element_type=jnp.float32) * scale
        p = jax.nn.softmax(jnp.concatenate([s_nb.reshape(B, H, GRID_W, n_nb), s_ctx], axis=-1),
                           axis=-1).astype(v.dtype)
        p_nb = p[..., :n_nb].reshape(B, H, GRID_W, win_r, NA_WIN_C)
        return (jnp.einsum('bhcij,bicjhd->bchd', p_nb, v_nb)
                + jnp.einsum('bhcl,blhd->bchd', p[..., n_nb:], v_ctx))

    o = lax.map(one_row, (jnp.arange(rows), qg))
    return o.transpose(1, 0, 2, 3, 4).reshape(B, S, H, dh)


def mla_mixer(u, uc, row, col, q_norm, kv_norm, w_uq, w_ukv, qn, kn, with_ctx_out):
    def project(t, pos):
        B, T, _ = t.shape
        q_c, kv_c, k_r = jnp.split(t, [MLA_Q_RANK, MLA_Q_RANK + MLA_KV_RANK], axis=-1)
        q = (rms_norm(q_c, q_norm) @ w_uq).reshape(B, T, MLA_HEADS, MLA_NOPE + MLA_ROPE)
        kv = (rms_norm(kv_c, kv_norm) @ w_ukv).reshape(B, T, MLA_HEADS, MLA_NOPE + MLA_V)
        k_rope = jnp.broadcast_to(k_r[:, :, None, :], (B, T, MLA_HEADS, MLA_ROPE))
        k = jnp.concatenate([kv[..., :MLA_NOPE], k_rope], axis=-1)
        v = kv[..., MLA_NOPE:]
        q, k = rms_norm(q, qn), rms_norm(k, kn)
        if pos is not None:
            q = jnp.concatenate([q[..., :MLA_NOPE], rope_2d(q[..., MLA_NOPE:], *pos)], axis=-1)
            k = jnp.concatenate([k[..., :MLA_NOPE], rope_2d(k[..., MLA_NOPE:], *pos)], axis=-1)
        return q, k, v

    B, S, _ = u.shape
    scale = (MLA_NOPE + MLA_ROPE) ** -0.5
    q, k, v = project(u, (row, col))
    qc, kc, vc = project(uc, None)
    o = blocked_attention(q, jnp.concatenate([kc, k], axis=1), jnp.concatenate([vc, v], axis=1), scale)
    o_ctx = blocked_attention(qc, kc, vc, scale).reshape(B, -1, GROUP_W) if with_ctx_out else None
    return o.reshape(B, S, GROUP_W), o_ctx


def token_shift(t, mu):
    prev = jnp.pad(t, ((0, 0), (1, 0), (0, 0)))[:, :-1]
    nxt = jnp.pad(t, ((0, 0), (0, 1), (0, 0)))[:, 1:]
    return t + mu[0] * (prev - t) + mu[1] * (nxt - t)


def rwkv_features(t, shift, w0, w2, a0, a2, g2, k_k, k_a):
    B, T, _ = t.shape
    t = token_shift(t, shift).astype(jnp.float32)
    r, k, v, wd_f, wd_b, ad_f, ad_b, gd = jnp.split(t, RWKV_SPLITS, axis=-1)
    heads = lambda z: z.reshape(B, T, RWKV_HEADS, RWKV_N)
    kk = heads(k * k_k)
    kk = kk * lax.rsqrt(jnp.sum(kk * kk, axis=-1, keepdims=True) + 1e-12)
    g = jax.nn.sigmoid(gd) @ g2
    dirs = []
    for d, (wd, ad) in enumerate(((wd_f, ad_f), (wd_b, ad_b))):
        w_log = -jax.nn.softplus(-(w0[d] + jnp.tanh(wd) @ w2[d])) - 0.5
        decay = jnp.exp(-jnp.exp(w_log))
        a = jax.nn.sigmoid(a0[d] + ad @ a2[d])
        kd = k * (1 + (a - 1) * k_a)
        dirs.append((heads(decay), heads(kd), heads(a)))
    return heads(r), heads(v), kk, g, dirs


def wkv_scan(state0, r, w, k, v, kk, a, reverse):
    xs = tuple(jnp.moveaxis(z, 1, 0) for z in (r, w, k, v, kk, a))

    def step(S, inp):
        r_t, w_t, k_t, v_t, kk_t, a_t = inp
        sa = jnp.einsum('bhij,bhj->bhi', S, kk_t)
        S = (S * w_t[:, :, None, :] - sa[..., None] * (kk_t * a_t)[:, :, None, :]
             + v_t[..., None] * k_t[:, :, None, :])
        return S, jnp.einsum('bhij,bhj->bhi', S, r_t)

    s_final, ys = lax.scan(step, state0, xs, reverse=reverse)
    return s_final, jnp.moveaxis(ys, 0, 1)


def head_group_norm(y, gain, bias):
    B, T, H, N = y.shape
    mu = jnp.mean(y, axis=-1, keepdims=True)
    var = jnp.mean(jnp.square(y - mu), axis=-1, keepdims=True)
    return ((y - mu) * lax.rsqrt(var + RWKV_LNX_EPS)).reshape(B, T, H * N) * gain + bias


def rwkv_mixer(u, uc, shift, w0, w2, a0, a2, g2, k_k, k_a, r_k, lnx_g, lnx_b, with_ctx_out):
    B, S, _ = u.shape
    r, v, kk, g, dirs = rwkv_features(u, shift, w0, w2, a0, a2, g2, k_k, k_a)
    rc, vc, kkc, gc, dirs_c = rwkv_features(uc, shift, w0, w2, a0, a2, g2, k_k, k_a)
    ys, ys_c, bon, bon_c = [], [], [], []
    for (dec, kd, a), (dec_c, kd_c, a_c), rev in zip(dirs, dirs_c, (False, True)):
        s0 = jnp.zeros((B, RWKV_HEADS, RWKV_N, RWKV_N), jnp.float32)
        s_ctx, y_c = wkv_scan(s0, rc, dec_c, kd_c, vc, kkc, a_c, rev)
        _, y = wkv_scan(s_ctx, r, dec, kd, v, kk, a, rev)
        ys.append(y)
        ys_c.append(y_c)
        bon.append(jnp.sum(r * kd * r_k, axis=-1, keepdims=True) * v)
        bon_c.append(jnp.sum(rc * kd_c * r_k, axis=-1, keepdims=True) * vc)
    o = (head_group_norm(ys[0] + ys[1], lnx_g, lnx_b) + (bon[0] + bon[1]).reshape(B, S, GROUP_W)) * g
    o_ctx = None
    if with_ctx_out:
        o_ctx = ((head_group_norm(ys_c[0] + ys_c[1], lnx_g, lnx_b)
                  + (bon_c[0] + bon_c[1]).reshape(B, -1, GROUP_W)) * gc).astype(uc.dtype)
    return o.astype(u.dtype), o_ctx


def na_mixer(u, uc, qn, kn, rpb, with_ctx_out):
    def heads(t):
        B, T, _ = t.shape
        q, k, v = (z.reshape(B, T, NA_HEADS, HEAD_DIM) for z in jnp.split(t, 3, axis=-1))
        return rms_norm(q, qn), rms_norm(k, kn), v

    B, S, _ = u.shape
    scale = HEAD_DIM ** -0.5
    q, k, v = heads(u)
    qc, kc, vc = heads(uc)
    o = neighbourhood_attention(q, k, v, kc, vc, rpb, scale)
    o_ctx = blocked_attention(qc, kc, vc, scale).reshape(B, -1, GROUP_W) if with_ctx_out else None
    return o.reshape(B, S, GROUP_W), o_ctx


def gqa_mixer(u, uc, row, col, qn, kn, with_ctx_out):
    def heads(t, pos):
        B, T, _ = t.shape
        q, k, v = jnp.split(t, [GQA_Q_HEADS * HEAD_DIM, (GQA_Q_HEADS + GQA_KV_HEADS) * HEAD_DIM], axis=-1)
        q = rms_norm(q.reshape(B, T, GQA_Q_HEADS, HEAD_DIM), qn)
        k = rms_norm(k.reshape(B, T, GQA_KV_HEADS, HEAD_DIM), kn)
        v = v.reshape(B, T, GQA_KV_HEADS, HEAD_DIM)
        if pos is not None:
            q, k = rope_2d(q, *pos), rope_2d(k, *pos)
        return q, k, v

    B, S, _ = u.shape
    scale = HEAD_DIM ** -0.5
    q, k, v = heads(u, (row, col))
    qc, kc, vc = heads(uc, None)
    o = blocked_attention(q, jnp.concatenate([kc, k], axis=1), jnp.concatenate([vc, v], axis=1), scale)
    o_ctx = blocked_attention(qc, kc, vc, scale).reshape(B, -1, GROUP_W) if with_ctx_out else None
    return o.reshape(B, S, GROUP_W), o_ctx


def setup_inputs(seed: int = 0) -> dict:
    key = jax.random.key(seed)
    ks = iter(jax.random.split(key, 64))
    nrm = lambda shape, s: jax.random.normal(next(ks), shape, jnp.float32) * s
    gain = lambda shape: 1.0 + nrm(shape, 0.1)
    L, D = DEPTH, D_MODEL
    return {
        'x': nrm((BATCH, SEQ, D), 1.0),
        'c': nrm((BATCH, D), 1.0),
        'ctx': nrm((BATCH, CTX_LEN, D), 1.0),
        'c_ctx': nrm((D,), 1.0),
        'w_mod': nrm((L, D, 9 * D), 0.5 * D ** -0.5),
        'b_mod': nrm((L, 9 * D), 0.02),
        'norm_ffn1': gain((L, D)),
        'ffn1_w_gu': nrm((L, D, 2 * D_FF), D ** -0.5),
        'ffn1_w_down': nrm((L, D_FF, D), D_FF ** -0.5),
        'norm_mix': gain((L, D)),
        'w_in': nrm((L, D, N_IN_COLS), D ** -0.5),
        'w_out': nrm((L, D_MIX, D), D_MIX ** -0.5),
        'mla_q_norm': gain((L, MLA_Q_RANK)),
        'mla_kv_norm': gain((L, MLA_KV_RANK)),
        'mla_w_uq': nrm((L, MLA_Q_RANK, MLA_HEADS * (MLA_NOPE + MLA_ROPE)), MLA_Q_RANK ** -0.5),
        'mla_w_ukv': nrm((L, MLA_KV_RANK, MLA_HEADS * (MLA_NOPE + MLA_V)), MLA_KV_RANK ** -0.5),
        'mla_qn': gain((L, MLA_NOPE + MLA_ROPE)),
        'mla_kn': gain((L, MLA_NOPE + MLA_ROPE)),
        'rwkv_shift': jax.random.uniform(next(ks), (L, 2, RWKV_COLS), jnp.float32, 0.0, 0.5),
        'rwkv_w0': jax.random.uniform(next(ks), (L, 2, GROUP_W), jnp.float32, -4.0, 1.0),
        'rwkv_w2': nrm((L, 2, RWKV_W_LORA, GROUP_W), 0.5 * RWKV_W_LORA ** -0.5),
        'rwkv_a0': nrm((L, 2, GROUP_W), 0.5),
        'rwkv_a2': nrm((L, 2, RWKV_A_LORA, GROUP_W), 0.5 * RWKV_A_LORA ** -0.5),
        'rwkv_g2': nrm((L, RWKV_G_LORA, GROUP_W), RWKV_G_LORA ** -0.5),
        'rwkv_k_k': 0.85 + nrm((L, GROUP_W), 0.1),
        'rwkv_k_a': 1.0 + nrm((L, GROUP_W), 0.1),
        'rwkv_r_k': nrm((L, RWKV_HEADS, RWKV_N), 0.1),
        'rwkv_lnx_g': gain((L, GROUP_W)),
        'rwkv_lnx_b': nrm((L, GROUP_W), 0.02),
        'na_qn': gain((L, HEAD_DIM)),
        'na_kn': gain((L, HEAD_DIM)),
        'na_rpb': nrm((L, NA_HEADS, 2 * NA_WIN_R - 1, 2 * NA_WIN_C - 1), 0.5),
        'gqa_qn': gain((L, HEAD_DIM)),
        'gqa_kn': gain((L, HEAD_DIM)),
        'norm_ffn2': gain((L, D)),
        'ffn2_w_gu': nrm((L, D, 2 * D_FF), D ** -0.5),
        'ffn2_w_down': nrm((L, D_FF, D), D_FF ** -0.5),
    }


def reference(x, c, ctx, c_ctx, w_mod, b_mod, norm_ffn1, ffn1_w_gu, ffn1_w_down, norm_mix, w_in, w_out,
              mla_q_norm, mla_kv_norm, mla_w_uq, mla_w_ukv, mla_qn, mla_kn,
              rwkv_shift, rwkv_w0, rwkv_w2, rwkv_a0, rwkv_a2, rwkv_g2, rwkv_k_k, rwkv_k_a, rwkv_r_k,
              rwkv_lnx_g, rwkv_lnx_b, na_qn, na_kn, na_rpb, gqa_qn, gqa_kn,
              norm_ffn2, ffn2_w_gu, ffn2_w_down):
    S = x.shape[1]
    t = jnp.arange(S)
    row, col = t // GRID_W, t % GRID_W
    h, hc = x, ctx
    for l in range(DEPTH):
        ctx_needed = l < DEPTH - 1
        m = jnp.split((jax.nn.silu(c) @ w_mod[l] + b_mod[l])[:, None, :], 9, axis=-1)
        mc = jnp.split(jax.nn.silu(c_ctx) @ w_mod[l] + b_mod[l], 9, axis=-1)

        h = h + 0.5 * m[2] * swiglu(modulate(rms_norm(h, norm_ffn1[l]), m[0], m[1]), ffn1_w_gu[l], ffn1_w_down[l])
        hc = hc + 0.5 * mc[2] * swiglu(modulate(rms_norm(hc, norm_ffn1[l]), mc[0], mc[1]),
                                       ffn1_w_gu[l], ffn1_w_down[l])

        u = modulate(rms_norm(h, norm_mix[l]), m[3], m[4]) @ w_in[l]
        uc = modulate(rms_norm(hc, norm_mix[l]), mc[3], mc[4]) @ w_in[l]
        ua, ub, ucn, ud = jnp.split(u, MIX_SPLITS, axis=-1)
        uca, ucb, uccn, ucd = jnp.split(uc, MIX_SPLITS, axis=-1)
        oa, oca = mla_mixer(ua, uca, row, col, mla_q_norm[l], mla_kv_norm[l], mla_w_uq[l], mla_w_ukv[l],
                            mla_qn[l], mla_kn[l], ctx_needed)
        ob, ocb = rwkv_mixer(ub, ucb, rwkv_shift[l], rwkv_w0[l], rwkv_w2[l], rwkv_a0[l], rwkv_a2[l],
                             rwkv_g2[l], rwkv_k_k[l], rwkv_k_a[l], rwkv_r_k[l], rwkv_lnx_g[l], rwkv_lnx_b[l],
                             ctx_needed)
        on, ocn = na_mixer(ucn, uccn, na_qn[l], na_kn[l], na_rpb[l], ctx_needed)
        od, ocd = gqa_mixer(ud, ucd, row, col, gqa_qn[l], gqa_kn[l], ctx_needed)
        mix = jnp.concatenate([oa, ob, on, od], axis=-1).astype(h.dtype) @ w_out[l]
        h = h + m[5] * mix
        if ctx_needed:
            mix_c = jnp.concatenate([oca, ocb, ocn, ocd], axis=-1).astype(hc.dtype) @ w_out[l]
            hc = hc + mc[5] * mix_c

        h = h + 0.5 * m[8] * swiglu(modulate(rms_norm(h, norm_ffn2[l]), m[6], m[7]), ffn2_w_gu[l], ffn2_w_down[l])
        if ctx_needed:
            hc = hc + 0.5 * mc[8] * swiglu(modulate(rms_norm(hc, norm_ffn2[l]), mc[6], mc[7]),
                                           ffn2_w_gu[l], ffn2_w_down[l])
    return h
```

```cpp
#include <hip/hip_runtime.h>
#include <hip/hip_cooperative_groups.h>
#include <cstdio>
namespace cg = cooperative_groups;

#define LAS __attribute__((address_space(3)))
#define DI __device__ __forceinline__
typedef unsigned short bf16_t;
typedef short bf16x8 __attribute__((ext_vector_type(8)));
typedef short s16x4 __attribute__((ext_vector_type(4)));
typedef float f32x4 __attribute__((ext_vector_type(4)));
typedef float f32x2 __attribute__((ext_vector_type(2)));
typedef float f32x16 __attribute__((ext_vector_type(16)));
typedef unsigned u32x4 __attribute__((ext_vector_type(4)));
typedef unsigned u32x2 __attribute__((ext_vector_type(2)));
typedef __bf16 bf2_t __attribute__((ext_vector_type(2)));

constexpr int NB = 2, SEQ = 8192, CTX = 256, TT = CTX + SEQ, MT = NB * TT, DM = 1024, DFF = 2816, NIN = 2656, NINP = 2816;
constexpr int GRIDW = 64;
constexpr int C_MLA = 0, C_RW = 416, C_NA = 1376, C_GQ = 2144;

constexpr size_t al256(size_t x) { return (x + 255) & ~(size_t)255; }
constexpr size_t WS_CTL = 0;
constexpr size_t WS_MOD = 16384;
constexpr size_t WS_HC = al256(WS_MOD + 2 * 3 * 9216 * 4);
constexpr size_t WS_WGU = al256(WS_HC + 512 * 1024 * 4);
constexpr size_t WS_WD = WS_WGU + 1ull * 5632 * 1024 * 2;
constexpr size_t WS_WIN = WS_WD + 1ull * 1024 * 2816 * 2;
constexpr size_t WS_WOUT = WS_WIN + 2816ull * 1024 * 2;
constexpr size_t WS_WMLA = WS_WOUT + 1024ull * 1024 * 2;
constexpr size_t WS_A = WS_WMLA + 1024ull * 384 * 2;
constexpr size_t WS_G = WS_A + (size_t)MT * 1024 * 2;
constexpr size_t WS_BON = WS_G + (size_t)MT * 256 * 2;
constexpr size_t WS_BIG = al256(WS_BON + (size_t)MT * 4 * 4);
constexpr size_t WS_U = WS_BIG;
constexpr size_t WS_YF = WS_BIG, WS_YB = WS_BIG + (size_t)MT * 256 * 4;
constexpr size_t WS_FS = WS_BIG + (size_t)MT * NINP * 2;
constexpr size_t WS_FD = WS_FS + (size_t)MT * 1024 * 2;
constexpr size_t WS_QA = WS_FD + (size_t)MT * 1024 * 2;
constexpr size_t WS_KA = WS_QA + (size_t)MT * 384 * 2;
constexpr size_t WS_VTA = WS_KA + (size_t)MT * 384 * 2;
constexpr size_t WS_QD = WS_VTA + (size_t)MT * 256 * 2;
constexpr size_t WS_KD = WS_QD + (size_t)MT * 256 * 2;
constexpr size_t WS_VTD = WS_KD + (size_t)MT * 128 * 2;
constexpr size_t WS_QC = WS_VTD + (size_t)MT * 128 * 2;
constexpr size_t WS_KC = WS_QC + (size_t)MT * 256 * 2;
constexpr size_t WS_VTC = WS_KC + (size_t)MT * 256 * 2;
constexpr size_t WS_END = WS_VTC + (size_t)MT * 256 * 2;
constexpr size_t WS_SLAB = WS_QA;
constexpr size_t WS_END2 = WS_END;
static_assert(8ull * 512 * 1024 * 4 <= 2 * (size_t)MT * 384 * 2, "slab overlay (QA + KA)");
constexpr size_t WS_HID = WS_BIG;
static_assert(WS_HID + (size_t)MT * DFF * 2 <= WS_FS, "hid overlay");
static_assert(WS_YB + (size_t)MT * 256 * 4 <= WS_FS, "y overlay");

constexpr int LDS_MAIN = 131072;
constexpr int LDS_BYTES = LDS_MAIN + 1024;

struct P { const float* in[37]; float* out; unsigned char* ws; };

DI float bf2f(bf16_t b) { return __uint_as_float(((unsigned)b) << 16); }
DI unsigned pack2(float lo, float hi) { f32x2 v = {lo, hi}; bf2_t b = __builtin_convertvector(v, bf2_t); return __builtin_bit_cast(unsigned, b); }
DI bf16_t f2bf(float x) { return (bf16_t)(pack2(x, 0.f) & 0xffffu); }
DI u32x2 pack4(float a, float b, float c, float d) { u32x2 r; r.x = pack2(a, b); r.y = pack2(c, d); return r; }
DI f32x4 unpack4(u32x2 v) { f32x4 r; r[0] = __uint_as_float(v.x << 16); r[1] = __uint_as_float(v.x & 0xffff0000u); r[2] = __uint_as_float(v.y << 16); r[3] = __uint_as_float(v.y & 0xffff0000u); return r; }
DI f32x4 ldbf4(const bf16_t* p) { return unpack4(*(const u32x2*)p); }
template <int CTRL> DI float dpp_add(float x) { return x + __builtin_bit_cast(float, __builtin_amdgcn_update_dpp(0, __builtin_bit_cast(int, x), CTRL, 0xf, 0xf, true)); }
DI float red16(float x) { x = dpp_add<0xB1>(x); x = dpp_add<0x4E>(x); x = dpp_add<0x141>(x); x = dpp_add<0x140>(x); return x; }
DI float red64(float x) { x = red16(x); x += __shfl_xor(x, 16); x += __shfl_xor(x, 32); return x; }
DI void lds_barrier() { asm volatile("s_waitcnt lgkmcnt(0)" ::: "memory"); __builtin_amdgcn_s_barrier(); asm volatile("" ::: "memory"); }
#define XB_XCNT(j) (256 + 64 * (j))
#define XB_XSUB(j) (1280 + 64 * (j))
#define XB_XGEN(j) (2304 + 64 * (j))
#define XB_TOP 3328
#define XB_TOPGEN 3392
#define XB_FLAT 3456
DI unsigned xb_ld(unsigned* p) { return __hip_atomic_load(p, __ATOMIC_RELAXED, __HIP_MEMORY_SCOPE_AGENT); }
DI unsigned xb_add(unsigned* p) { return __hip_atomic_fetch_add(p, 1u, __ATOMIC_RELAXED, __HIP_MEMORY_SCOPE_AGENT); }
DI unsigned xb_xcc_id() { return (unsigned)__builtin_amdgcn_s_getreg((3 << 11) | 20) & 0xFu; }
struct XBar { unsigned* bar; unsigned x, nloc, nx, epoch; };
DI void grid_bar(XBar& B) {
    asm volatile("s_waitcnt vmcnt(0)" ::: "memory");
    __syncthreads();
    B.epoch += 1;
    if (threadIdx.x == 0) {
        const unsigned e = B.epoch;
        const unsigned a = xb_add(B.bar + XB_XSUB(B.x)) + 1u;
        if (a == e * B.nloc) {
            __builtin_amdgcn_fence(__ATOMIC_RELEASE, "agent");
            asm volatile("s_waitcnt vmcnt(0)" ::: "memory");
            const unsigned t = xb_add(B.bar + XB_TOP) + 1u;
            if (t == e * B.nx) __hip_atomic_store(B.bar + XB_TOPGEN, e, __ATOMIC_RELAXED, __HIP_MEMORY_SCOPE_AGENT);
            else while (xb_ld(B.bar + XB_TOPGEN) < e) __builtin_amdgcn_s_sleep(1);
            __hip_atomic_store(B.bar + XB_XGEN(B.x), e, __ATOMIC_RELAXED, __HIP_MEMORY_SCOPE_AGENT);
        } else while (xb_ld(B.bar + XB_XGEN(B.x)) < e) __builtin_amdgcn_s_sleep(1);
        __builtin_amdgcn_fence(__ATOMIC_ACQUIRE, "agent");
        asm volatile("s_waitcnt vmcnt(0)" ::: "memory");
    }
    __syncthreads();
}
DI int oz() { int z; asm volatile("s_mov_b32 %0, 0" : "=s"(z)); return z; }
DI float sigm(float x) { return __builtin_amdgcn_rcpf(1.0f + __expf(-x)); }
DI float* hrow(const P& p, int g) { const int b = g / TT, t = g - b * TT; return t < CTX ? (float*)(p.ws + WS_HC) + (size_t)(b * CTX + t) * DM : p.out + (size_t)(b * SEQ + t - CTX) * DM; }
DI const float* modp(const P& p, int l, int mrow, int j) { return (const float*)(p.ws + WS_MOD) + (size_t)(l * 3 + mrow) * 9216 + j * 1024; }

namespace pg8 {
constexpr int BM = 256, BK = 64, HALF = 128, HTB = HALF * BK * 2, STAGE_BYTES = 8 * HTB, NXCD = 8, WGM = 8;
DI int lds_byte(int r, int c) { const int st = (r >> 4) * 2 + (c >> 5), rr = r & 15, cc = c & 31, ob = rr * 64 + cc * 2; return st * 1024 + (ob ^ (((ob >> 9) & 1) << 5)); }
DI void stage_rc(int b, int& R, int& C) { const int st = b / 1024, sb = b % 1024, swz = sb ^ (((sb >> 9) & 1) << 5); R = (st >> 1) * 16 + swz / 64; C = (st & 1) * 32 + (swz % 64) / 2; }
struct Unit { int pm, pn, k0, nt, part; };
struct Gemm { const bf16_t* A; const bf16_t* Bt; int M, N, K, lda; };
struct StaticOrder {
    int nM, nN, nwg, G, c, mode, ntfull, ntot, nsl;
    DI void init(int M, int N, int K, int G_, int c_, int mode_ = 0, int nsl_ = 4) { mode = mode_; nsl = nsl_; nM = M / BM - (mode_ ? 2 : 0); nN = N / BM; nwg = nM * nN; G = G_; c = c_; ntfull = K / BK; ntot = nwg + (mode_ == 2 ? 2 * nN * nsl_ : 0); }
    DI bool next(int i, Unit& u) const {
        const long L = (long)i * G + c; if (L >= ntot) return false;
        const bool part = L >= nwg;
        const int q = part ? (int)L - nwg : 0, cu = q / nsl, ch = q - cu * nsl, base = (ntfull / nsl) & ~1, rem2 = (ntfull - nsl * base) / 2;
        const int ppm = (cu / nN) ? 33 : 0, ppn = cu % nN, pnt = base + (ch < rem2 ? 2 : 0), pk0 = (ch * base + 2 * (ch < rem2 ? ch : rem2)) * BK;
        int wgid = part ? 0 : (int)L; { const int qq = nwg / NXCD, r = nwg % NXCD, xcd = wgid % NXCD, off = wgid / NXCD; wgid = (xcd < r ? xcd * (qq + 1) : r * (qq + 1) + (xcd - r) * qq) + off; }
        const int nig = WGM * nN, gid = wgid / nig, fm = gid * WGM, gsz = (nM - fm) < WGM ? (nM - fm) : WGM;
        int mpm = fm + ((wgid % nig) % gsz); const int mpn = (wgid % nig) / gsz; if (mode) mpm += 1 + (mpm >= 32 ? 1 : 0);
        u.pm = part ? ppm : mpm; u.pn = part ? ppn : mpn; u.k0 = part ? pk0 : 0; u.nt = part ? pnt : ntfull; u.part = __builtin_amdgcn_readfirstlane(part ? ch + 1 : 0);
        return true;
    }
};
template <class Epi>
DI void gemm_phase(LAS unsigned char* lds, const Gemm g, const StaticOrder& S, const Epi& E) {
    const int tid = threadIdx.x + oz(), wid = __builtin_amdgcn_readfirstlane(tid >> 6), lane = tid & 63, wr = wid >> 2, wc = wid & 3, fr = lane & 15, fq = lane >> 4;
    const int K = g.K, lda = g.lda;
    unsigned voffA[2], voffB[2];
#pragma unroll
    for (int i = 0; i < 2; ++i) { int R, C; stage_rc(tid * 16 + i * 8192, R, C); voffA[i] = (unsigned)(R * lda + C) * 2u; voffB[i] = (unsigned)(R * K + C) * 2u; }
    const size_t kstep = (size_t)(BK * 2);
    const size_t hstepA = (size_t)HALF * lda * 2, hstepB = (size_t)HALF * K * 2;
    const size_t tstepA = 2 * hstepA, tstepB = 2 * hstepB;
    const unsigned ldsw = (unsigned)wid * 1024u;
    const int aoff = lds_byte(wr * 64 + fr, fq * 8), boff = lds_byte(wc * 32 + fr, fq * 8);
#define PG8_SA(b, h) (((b) * 2 + (h)) * HTB)
#define PG8_SB(b, h) ((4 + (b) * 2 + (h)) * HTB)
#define PG8_STAGE(bufoff, gbase, voff) do { _Pragma("unroll") for (int _i = 0; _i < 2; ++_i) \
        __builtin_amdgcn_global_load_lds((const unsigned*)((const char*)(gbase) + (voff)[_i]), (LAS unsigned*)(lds + (bufoff) + ldsw + _i * 8192), 16, 0, 0); } while (0)
#define PG8_LDA(dst, b, h) do { _Pragma("unroll") for (int m = 0; m < 4; ++m) _Pragma("unroll") for (int k = 0; k < 2; ++k) dst[m][k] = *(const LAS bf16x8*)(lds + PG8_SA(b, h) + aoff + m * 2048 + k * 1024); } while (0)
#define PG8_LDB(dst, b, h) do { _Pragma("unroll") for (int n = 0; n < 2; ++n) _Pragma("unroll") for (int k = 0; k < 2; ++k) dst[n][k] = *(const LAS bf16x8*)(lds + PG8_SB(b, h) + boff + n * 2048 + k * 1024); } while (0)
#define PG8_MMA(ai, bj, At, Bt) do { __builtin_amdgcn_s_setprio(1); _Pragma("unroll") for (int m = 0; m < 4; ++m) _Pragma("unroll") for (int n = 0; n < 2; ++n) _Pragma("unroll") for (int k = 0; k < 2; ++k) \
        acc[ai][bj][m][n] = __builtin_amdgcn_mfma_f32_16x16x32_bf16(Bt[n][k], At[m][k], acc[ai][bj][m][n], 0, 0, 0); __builtin_amdgcn_s_setprio(0); } while (0)
#define PG8_WAIT_V(n) asm volatile("s_waitcnt vmcnt(" #n ")" ::: "memory")
#define PG8_WAIT_L(n) asm volatile("s_waitcnt lgkmcnt(" #n ")" ::: "memory")
#define PG8_BAR __builtin_amdgcn_s_barrier()
#define PG8_SCHED __builtin_amdgcn_sched_barrier(0)
    Unit cur, nxt; int ui = 0;
    if (!S.next(0, cur)) return;
    f32x4 acc[2][2][4][2];
#pragma unroll
    for (int a = 0; a < 2; ++a)
#pragma unroll
        for (int b = 0; b < 2; ++b)
#pragma unroll
            for (int m = 0; m < 4; ++m)
#pragma unroll
                for (int n = 0; n < 2; ++n) acc[a][b][m][n] = (f32x4){0.f, 0.f, 0.f, 0.f};
    bf16x8 At[4][2], B0[2][2], B1[2][2];
    const char* cA = (const char*)g.A + (size_t)cur.pm * tstepA + (size_t)cur.k0 * 2; const char* cB = (const char*)g.Bt + (size_t)cur.pn * tstepB + (size_t)cur.k0 * 2;
    PG8_STAGE(PG8_SB(0, 0), cB, voffB); PG8_STAGE(PG8_SA(0, 0), cA, voffA); PG8_STAGE(PG8_SB(0, 1), cB + hstepB, voffB); PG8_STAGE(PG8_SA(0, 1), cA + hstepA, voffA);
    if (wr == 1) PG8_BAR;
    PG8_WAIT_V(4); PG8_BAR;
    PG8_STAGE(PG8_SB(1, 0), cB + kstep, voffB); PG8_STAGE(PG8_SA(1, 0), cA + kstep, voffA); PG8_STAGE(PG8_SB(1, 1), cB + hstepB + kstep, voffB);
    PG8_WAIT_V(6); PG8_BAR;
    for (;;) {
        const bool has_next = S.next(ui + 1, nxt);
        const char* nA = has_next ? (const char*)g.A + (size_t)nxt.pm * tstepA + (size_t)nxt.k0 * 2 : cA; const char* nB = has_next ? (const char*)g.Bt + (size_t)nxt.pn * tstepB + (size_t)nxt.k0 * 2 : cB;
        const int nt = cur.nt;
        for (int t = 0; t < nt; t += 2) {
            const bool last = (t == nt - 2);
            const char* a1 = cA + (size_t)(t + 1) * kstep;
            const char* a2 = last ? nA : cA + (size_t)(t + 2) * kstep; const char* b2 = last ? nB : cB + (size_t)(t + 2) * kstep;
            const char* a3 = a2 + kstep; const char* b3 = b2 + kstep;
            PG8_LDB(B0, 0, 0); PG8_SCHED; PG8_LDA(At, 0, 0); PG8_STAGE(PG8_SA(1, 1), a1 + hstepA, voffA);
            PG8_WAIT_L(8); PG8_BAR; PG8_WAIT_L(0); PG8_MMA(0, 0, At, B0); PG8_BAR; PG8_SCHED;
            PG8_LDB(B1, 0, 1); PG8_STAGE(PG8_SB(0, 0), b2, voffB);
            PG8_BAR; PG8_WAIT_L(0); PG8_MMA(0, 1, At, B1); PG8_BAR;
            PG8_LDA(At, 0, 1); PG8_STAGE(PG8_SA(0, 0), a2, voffA);
            PG8_BAR; PG8_WAIT_L(0); PG8_MMA(1, 0, At, B0); PG8_BAR; PG8_SCHED;
            PG8_STAGE(PG8_SB(0, 1), b2 + hstepB, voffB);
            PG8_WAIT_V(6); PG8_BAR; PG8_MMA(1, 1, At, B1); PG8_BAR;
            PG8_LDB(B0, 1, 0); PG8_SCHED; PG8_LDA(At, 1, 0); PG8_STAGE(PG8_SA(0, 1), a2 + hstepA, voffA);
            PG8_WAIT_L(8); PG8_BAR; PG8_WAIT_L(0); PG8_MMA(0, 0, At, B0); PG8_BAR; PG8_SCHED;
            PG8_LDB(B1, 1, 1); PG8_STAGE(PG8_SB(1, 0), b3, voffB);
            PG8_BAR; PG8_WAIT_L(0); PG8_MMA(0, 1, At, B1); PG8_BAR;
            PG8_LDA(At, 1, 1); PG8_STAGE(PG8_SA(1, 0), a3, voffA);
            PG8_BAR; PG8_WAIT_L(0); PG8_MMA(1, 0, At, B0); PG8_BAR; PG8_SCHED;
            PG8_STAGE(PG8_SB(1, 1), b3 + hstepB, voffB);
            PG8_WAIT_V(6); PG8_BAR; PG8_MMA(1, 1, At, B1); PG8_BAR;
        }
        E(acc, cur, wr, wc, fr, fq);
        if (!has_next) break;
#pragma unroll
        for (int a = 0; a < 2; ++a)
#pragma unroll
            for (int b = 0; b < 2; ++b)
#pragma unroll
                for (int m = 0; m < 4; ++m)
#pragma unroll
                    for (int n = 0; n < 2; ++n) acc[a][b][m][n] = (f32x4){0.f, 0.f, 0.f, 0.f};
        cur = nxt; cA = nA; cB = nB; ++ui;
    }
    PG8_WAIT_V(0);
    if (wr == 0) PG8_BAR;
    PG8_BAR;
#undef PG8_SA
#undef PG8_SB
#undef PG8_STAGE
#undef PG8_LDA
#undef PG8_LDB
#undef PG8_MMA
#undef PG8_WAIT_V
#undef PG8_WAIT_L
#undef PG8_BAR
#undef PG8_SCHED
}
}
using pg8::Unit;

struct EpiSwiGLU {
    bf16_t* hid;
    DI void operator()(const f32x4 (&acc)[2][2][4][2], const Unit& u, int wr, int wc, int fr, int fq) const {
#pragma unroll
        for (int ai = 0; ai < 2; ++ai)
#pragma unroll
            for (int m = 0; m < 4; ++m) {
                const int row = u.pm * 256 + ai * 128 + wr * 64 + m * 16 + fr;
#pragma unroll
                for (int n = 0; n < 2; ++n) {
                    const f32x4 gt = acc[ai][0][m][n], up = acc[ai][1][m][n]; float o[4];
#pragma unroll
                    for (int i = 0; i < 4; ++i) o[i] = gt[i] * sigm(gt[i]) * up[i];
                    *(u32x2*)(hid + (size_t)row * DFF + u.pn * 128 + wc * 32 + n * 16 + fq * 4) = pack4(o[0], o[1], o[2], o[3]);
                }
            }
    }
};
struct EpiResid {
    const float* gate0; float* hc; float* out; const float* hc_src; const float* out_src; float* slab; float coef; int skip_ctx;
    DI void operator()(const f32x4 (&acc)[2][2][4][2], const Unit& u, int wr, int wc, int fr, int fq) const {
        const int b = u.pm / 33, pt = u.pm - b * 33; const int mrow = pt == 0 ? 2 : b;
        if (pt == 0 && skip_ctx) return;
        const float* gate = gate0 + (size_t)mrow * 9216;
        if (u.part) {
            float* base = slab + ((size_t)(u.part - 1) * 512 + (size_t)b * CTX) * DM; const int col0 = u.pn * 256 + wc * 32 + 4 * fq;
#pragma unroll
            for (int ai = 0; ai < 2; ++ai)
#pragma unroll
                for (int m = 0; m < 4; ++m) {
                    float* rowp = base + (size_t)(ai * 128 + wr * 64 + m * 16 + fr) * DM + col0;
#pragma unroll
                    for (int bj = 0; bj < 2; ++bj)
#pragma unroll
                        for (int n = 0; n < 2; ++n) {
                            const f32x4 gv = *(const f32x4*)(gate + col0 + bj * 128 + n * 16);
                            *(f32x4*)(rowp + bj * 128 + n * 16) = coef * gv * acc[ai][bj][m][n];
                        }
                }
            return;
        }
        const size_t boff = pt == 0 ? (size_t)(b * CTX) * DM : (size_t)(b * SEQ + (pt - 1) * 256) * DM;
        float* base = (pt == 0 ? hc : out) + boff; const float* sbase = (pt == 0 ? hc_src : out_src) + boff;
        const int col0 = u.pn * 256 + wc * 32 + 4 * fq;
#pragma unroll
        for (int ai = 0; ai < 2; ++ai)
#pragma unroll
            for (int m = 0; m < 4; ++m) {
                const size_t roff = (size_t)(ai * 128 + wr * 64 + m * 16 + fr) * DM + col0;
                float* rowp = base + roff; const float* srow = sbase + roff;
#pragma unroll
                for (int bj = 0; bj < 2; ++bj)
#pragma unroll
                    for (int n = 0; n < 2; ++n) {
                        const f32x4 gv = *(const f32x4*)(gate + col0 + bj * 128 + n * 16);
                        f32x4 h = *(const f32x4*)(srow + bj * 128 + n * 16);
                        h += coef * gv * acc[ai][bj][m][n];
                        *(f32x4*)(rowp + bj * 128 + n * 16) = h;
                    }
            }
    }
};
struct EpiBf {
    bf16_t* O; int ldo;
    DI void operator()(const f32x4 (&acc)[2][2][4][2], const Unit& u, int wr, int wc, int fr, int fq) const {
        const int col0 = u.pn * 256 + wc * 32 + 4 * fq;
#pragma unroll
        for (int ai = 0; ai < 2; ++ai)
#pragma unroll
            for (int m = 0; m < 4; ++m) {
                bf16_t* rowp = O + (size_t)(u.pm * 256 + ai * 128 + wr * 64 + m * 16 + fr) * ldo + col0;
#pragma unroll
                for (int bj = 0; bj < 2; ++bj)
#pragma unroll
                    for (int n = 0; n < 2; ++n) { const f32x4 v = acc[ai][bj][m][n]; *(u32x2*)(rowp + bj * 128 + n * 16) = pack4(v[0], v[1], v[2], v[3]); }
            }
    }
};

DI void phase_mod(const P& p, float* lf) {
    const int tid = threadIdx.x + oz(), lane = tid & 63, wave = tid >> 6;
    for (int i = tid; i < 3072; i += 512) { const int v = i >> 10, k = i & 1023; const float x = v < 2 ? p.in[1][v * 1024 + k] : p.in[3][k]; lf[i] = x * sigm(x); }
    __syncthreads();
    float* red = lf + 3072;
    for (int unit = blockIdx.x; unit < 288; unit += gridDim.x) {
        const int l = unit / 144, n0 = (unit % 144) * 64;
        const float* W = p.in[4] + (size_t)l * 1024 * 9216 + n0 + lane;
        float a0 = 0.f, a1 = 0.f, a2 = 0.f;
        const int k0 = wave * 128;
#pragma unroll 32
        for (int k = k0; k < k0 + 128; ++k) { const float w = W[(size_t)k * 9216]; a0 += lf[k] * w; a1 += lf[1024 + k] * w; a2 += lf[2048 + k] * w; }
        red[(wave * 3 + 0) * 64 + lane] = a0; red[(wave * 3 + 1) * 64 + lane] = a1; red[(wave * 3 + 2) * 64 + lane] = a2;
        __syncthreads();
        if (tid < 192) { const int v = tid >> 6; float s = 0.f;
#pragma unroll
            for (int w = 0; w < 8; ++w) s += red[(w * 3 + v) * 64 + lane];
            ((float*)(p.ws + WS_MOD))[(size_t)(l * 3 + v) * 9216 + n0 + lane] = s + p.in[5][l * 9216 + n0 + lane]; }
        __syncthreads();
    }
}
DI void phase_hinit(const P& p) {
    const size_t gt = (size_t)blockIdx.x * 512 + threadIdx.x + oz(), gs = (size_t)gridDim.x * 512;
    const f32x4* x4 = (const f32x4*)p.in[0]; f32x4* o4 = (f32x4*)p.out;
    for (size_t i = gt; i < (size_t)NB * SEQ * DM / 4; i += gs) o4[i] = x4[i];
    const f32x4* c4 = (const f32x4*)p.in[2]; f32x4* h4 = (f32x4*)(p.ws + WS_HC);
    for (size_t i = gt; i < (size_t)NB * CTX * DM / 4; i += gs) h4[i] = c4[i];
}
template <class F> DI void conv_tiles(bf16_t* dst, int Np, int K, F f, float* tile, int& tcount) {
    const int tid = threadIdx.x + oz(), nkt = K / 64, ntile = (Np / 64) * nkt;
    const int G_ = (int)gridDim.x, first_ = (((int)blockIdx.x - tcount) % G_ + G_) % G_;
    tcount += ntile;
    for (int ti = first_; ti < ntile; ti += G_) {
        const int n0 = (ti / nkt) * 64, k0 = (ti % nkt) * 64;
        const int ty = tid >> 6, tx = tid & 63;
#pragma unroll
        for (int i = 0; i < 8; ++i) tile[(ty * 8 + i) * 65 + tx] = f(k0 + ty * 8 + i, n0 + tx);
        __syncthreads();
        const int r = tid >> 3, c8 = (tid & 7) * 8;
        u32x4 w; w.x = pack2(tile[(c8 + 0) * 65 + r], tile[(c8 + 1) * 65 + r]); w.y = pack2(tile[(c8 + 2) * 65 + r], tile[(c8 + 3) * 65 + r]);
        w.z = pack2(tile[(c8 + 4) * 65 + r], tile[(c8 + 5) * 65 + r]); w.w = pack2(tile[(c8 + 6) * 65 + r], tile[(c8 + 7) * 65 + r]);
        *(u32x4*)(dst + (size_t)(n0 + r) * K + k0 + c8) = w;
        __syncthreads();
    }
}
template <class F> DI void conv_tiles4(bf16_t* dst, int Np, int K, F f, float* tile, int& tcount) {
    const int tid = threadIdx.x + oz(), nkt = K / 256, ntile = (Np / 64) * nkt;
    for (int ti = 0; ti < ntile; ++ti, ++tcount) {
        if ((tcount % (int)gridDim.x) != (int)blockIdx.x) continue;
        const int n0 = (ti / nkt) * 64, k0 = (ti % nkt) * 256;
        const int ty = tid >> 6, tx = tid & 63;
        float v[32];
#pragma unroll
        for (int i = 0; i < 32; ++i) v[i] = f(k0 + ty * 32 + i, n0 + tx);
#pragma unroll
        for (int i = 0; i < 32; ++i) tile[(ty * 32 + i) * 65 + tx] = v[i];
        __syncthreads();
        const int r = tid >> 3;
#pragma unroll
        for (int q = 0; q < 4; ++q) {
            const int c8 = (tid & 7) * 8 + 64 * q;
            u32x4 w; w.x = pack2(tile[(c8 + 0) * 65 + r], tile[(c8 + 1) * 65 + r]); w.y = pack2(tile[(c8 + 2) * 65 + r], tile[(c8 + 3) * 65 + r]);
            w.z = pack2(tile[(c8 + 4) * 65 + r], tile[(c8 + 5) * 65 + r]); w.w = pack2(tile[(c8 + 6) * 65 + r], tile[(c8 + 7) * 65 + r]);
            *(u32x4*)(dst + (size_t)(n0 + r) * K + k0 + c8) = w;
        }
        __syncthreads();
    }
}
template <class F4> DI void conv_tilesN(bf16_t* dst, int Np, int K, F4 f4, float* tile, int& tcount) {
    const int tid = threadIdx.x + oz(), nkt = K / 64, ntile = (Np / 256) * nkt;
    const int G_ = (int)gridDim.x, first_ = (((int)blockIdx.x - tcount) % G_ + G_) % G_;
    tcount += ntile;
    for (int ti = first_; ti < ntile; ti += G_) {
        const int n0 = (ti / nkt) * 256, k0 = (ti % nkt) * 64;
        const int ty = tid >> 6, tx = tid & 63;
        f32x4 v[8];
#pragma unroll
        for (int i = 0; i < 8; ++i) v[i] = f4(k0 + ty * 8 + i, n0 + tx * 4);
#pragma unroll
        for (int i = 0; i < 8; ++i) { float* t_ = tile + (ty * 8 + i) * 257 + tx * 4; t_[0] = v[i][0]; t_[1] = v[i][1]; t_[2] = v[i][2]; t_[3] = v[i][3]; }
        __syncthreads();
        const int r = tid >> 1, kh = (tid & 1) * 32;
#pragma unroll
        for (int q = 0; q < 4; ++q) {
            const int kb = kh + q * 8;
            u32x4 w; w.x = pack2(tile[(kb + 0) * 257 + r], tile[(kb + 1) * 257 + r]); w.y = pack2(tile[(kb + 2) * 257 + r], tile[(kb + 3) * 257 + r]);
            w.z = pack2(tile[(kb + 4) * 257 + r], tile[(kb + 5) * 257 + r]); w.w = pack2(tile[(kb + 6) * 257 + r], tile[(kb + 7) * 257 + r]);
            *(u32x4*)(dst + (size_t)(n0 + r) * K + k0 + kb) = w;
        }
        __syncthreads();
    }
}
DI void phase_weights(const P& p, int l, int part, float* tile) {
    int tc = 0;
    const f32x4 z4 = {0.f, 0.f, 0.f, 0.f};
    {
        const float* Wgu = p.in[part ? 35 : 7] + (size_t)l * DM * 2 * DFF;
        conv_tilesN((bf16_t*)(p.ws + WS_WGU), 5632, 1024,
                    [=](int k, int n) { const int pp = n >> 8, hf = (n >> 7) & 1, j = n & 127; return *(const f32x4*)(Wgu + (size_t)k * 5632 + hf * DFF + pp * 128 + j); }, tile, tc);
        const float* Wd = p.in[part ? 36 : 8] + (size_t)l * DFF * DM;
        conv_tilesN((bf16_t*)(p.ws + WS_WD), 1024, DFF, [=](int k, int n) { return *(const f32x4*)(Wd + (size_t)k * 1024 + n); }, tile, tc);
    }
    if (part) return;
    const float* Win = p.in[10] + (size_t)l * DM * NIN;
    conv_tilesN((bf16_t*)(p.ws + WS_WIN), NINP, 1024, [=](int k, int n) { return n < NIN ? *(const f32x4*)(Win + (size_t)k * NIN + n) : z4; }, tile, tc);
    const float* Wo = p.in[11] + (size_t)l * DM * DM;
    conv_tilesN((bf16_t*)(p.ws + WS_WOUT), 1024, 1024, [=](int k, int n) { return *(const f32x4*)(Wo + (size_t)k * 1024 + n); }, tile, tc);
    const float* qn = p.in[12] + l * 256; const float* kvn = p.in[13] + l * 128; const float* wuq = p.in[14] + (size_t)l * 256 * 384; const float* wukv = p.in[15] + (size_t)l * 128 * 512;
    conv_tiles((bf16_t*)(p.ws + WS_WMLA), 1024, 384, [=](int k, int n) {
        float v = 0.f;
        if (n < 384) { if (k < 256) v = qn[k] * wuq[k * 384 + n]; }
        else if (n < 896) { if (k >= 256) v = kvn[k - 256] * wukv[(k - 256) * 512 + (n - 384)]; }
        return v; }, tile, tc);
}

DI void phase_norm(const P& p, int l, int which, int first = 0, int fold = 0) {
    const int tid_ = threadIdx.x + oz(), lane = tid_ & 63, wave = tid_ >> 6;
    const float* gain = p.in[which == 0 ? 6 : (which == 1 ? 9 : 34)] + l * DM;
    bf16_t* A = (bf16_t*)(p.ws + WS_A);
    f32x4 gv[4];
#pragma unroll
    for (int i = 0; i < 4; ++i) gv[i] = *(const f32x4*)(gain + (lane + 64 * i) * 4);
    for (int g0 = (blockIdx.x * 8 + wave) * 2; g0 < MT; g0 += gridDim.x * 16) {
        f32x4 x[2][4];
#pragma unroll
        for (int rr = 0; rr < 2; ++rr) { const int gg_ = g0 + rr, bb_ = gg_ / TT, tt_ = gg_ - bb_ * TT;
            const float* h = first ? (tt_ < CTX ? p.in[2] + (size_t)(bb_ * CTX + tt_) * DM : p.in[0] + (size_t)(bb_ * SEQ + tt_ - CTX) * DM) : (const float*)hrow(p, gg_);
#pragma unroll
            for (int i = 0; i < 4; ++i) x[rr][i] = *(const f32x4*)(h + (lane + 64 * i) * 4);
            if (fold && tt_ < CTX) {
                const float* sl = (const float*)(p.ws + WS_SLAB) + (size_t)(bb_ * CTX + tt_) * DM; float* hw = (float*)(p.ws + WS_HC) + (size_t)(bb_ * CTX + tt_) * DM;
#pragma unroll
                for (int i = 0; i < 4; ++i) {
#pragma unroll
                    for (int sidx = 0; sidx < 8; ++sidx) if (sidx < fold) x[rr][i] += *(const f32x4*)(sl + (size_t)sidx * 512 * DM + (lane + 64 * i) * 4);
                    *(f32x4*)(hw + (lane + 64 * i) * 4) = x[rr][i];
                }
            } }
#pragma unroll
        for (int rr = 0; rr < 2; ++rr) {
            const int g = g0 + rr, b = g / TT, t = g - b * TT, mrow = t < CTX ? 2 : b;
            const float* sh = modp(p, l, mrow, which * 3); const float* sc = modp(p, l, mrow, which * 3 + 1);
            float ss = 0.f;
#pragma unroll
            for (int i = 0; i < 4; ++i) ss += x[rr][i][0] * x[rr][i][0] + x[rr][i][1] * x[rr][i][1] + x[rr][i][2] * x[rr][i][2] + x[rr][i][3] * x[rr][i][3];
            ss = red64(ss);
            const float rinv = rsqrtf(ss * (1.0f / DM) + 1e-6f);
#pragma unroll
            for (int i = 0; i < 4; ++i) {
                const f32x4 s4 = *(const f32x4*)(sc + (lane + 64 * i) * 4), h4 = *(const f32x4*)(sh + (lane + 64 * i) * 4);
                const f32x4 y = (x[rr][i] * rinv * gv[i]) * (1.0f + s4) + h4;
                *(u32x2*)(A + (size_t)g * DM + (lane + 64 * i) * 4) = pack4(y[0], y[1], y[2], y[3]);
            }
        }
    }
}

constexpr int VLS = 40, PT = 32;
DI void vt_flush(const bf16_t* lv, bf16_t* Vt, int nch, int b, int t0) {
    const int tid = threadIdx.x + oz();
    for (int idx = tid; idx < nch * 4; idx += 512) {
        const int c = idx >> 2, q = idx & 3;
        *(u32x4*)(Vt + ((size_t)b * nch + c) * TT + t0 + q * 8) = *(const u32x4*)(lv + c * VLS + q * 8);
    }
}
DI void lv_put(bf16_t* lv, int ch0, int tl, u32x2 v) {
    lv[(ch0 + 0) * VLS + tl] = (bf16_t)(v.x & 0xffff); lv[(ch0 + 1) * VLS + tl] = (bf16_t)(v.x >> 16);
    lv[(ch0 + 2) * VLS + tl] = (bf16_t)(v.y & 0xffff); lv[(ch0 + 3) * VLS + tl] = (bf16_t)(v.y >> 16);
}
DI void rope_tab(int i, int half, float pos, float& cs, float& sn) {
    const float inv = exp2f(-13.287712379549449f * (float)i / (float)half);
    const float ang = pos * inv, rev = ang * 0.15915494309189535f;
    cs = __builtin_amdgcn_cosf(rev); sn = __builtin_amdgcn_sinf(rev);
}
DI f32x4 rw_shift(const bf16_t* u, int c, bool hp, bool hn, const float* mu) {
    const f32x4 z4 = {0.f, 0.f, 0.f, 0.f};
    const f32x4 x = ldbf4(u + c), xp = hp ? ldbf4(u - NINP + c) : z4, xn = hn ? ldbf4(u + NINP + c) : z4;
    const f32x4 m0 = *(const f32x4*)(mu + c), m1 = *(const f32x4*)(mu + 960 + c);
    return x + m0 * (xp - x) + m1 * (xn - x);
}
DI void phase_prep1(const P& p, int l, unsigned char* ldsb) {
    const int tid = threadIdx.x + oz(), lane = tid & 63, wave = tid >> 6, l15 = lane & 15;
    const bf16_t* U = (const bf16_t*)(p.ws + WS_U);
    bf16_t* lvC = (bf16_t*)ldsb;
    bf16_t* lvD = lvC + 256 * VLS;
    bf16_t* wl = (bf16_t*)ldsb;
    float* lora = (float*)(ldsb + 192 * 256 * 2);
    float* mylora = lora + wave * 768;
    const float* mu = p.in[18] + (size_t)l * 2 * 960;
    const float* w0 = p.in[19] + l * 512; const float* w2 = p.in[20] + (size_t)l * 2 * 32 * 256; const float* a0 = p.in[21] + l * 512; const float* a2 = p.in[22] + (size_t)l * 2 * 32 * 256;
    const float* g2 = p.in[23] + (size_t)l * 64 * 256; const float* k_k = p.in[24] + l * 256; const float* k_a = p.in[25] + l * 256; const float* r_k = p.in[26] + l * 256;
    bf16_t* QC = (bf16_t*)(p.ws + WS_QC); bf16_t* KC = (bf16_t*)(p.ws + WS_KC); bf16_t* QD = (bf16_t*)(p.ws + WS_QD); bf16_t* KD = (bf16_t*)(p.ws + WS_KD);
    bf16_t* FS = (bf16_t*)(p.ws + WS_FS); bf16_t* FD = (bf16_t*)(p.ws + WS_FD); bf16_t* G = (bf16_t*)(p.ws + WS_G); float* BON = (float*)(p.ws + WS_BON);
    const f32x4 nqn = *(const f32x4*)(p.in[29] + l * 64 + l15 * 4), nkn = *(const f32x4*)(p.in[30] + l * 64 + l15 * 4), gqn = *(const f32x4*)(p.in[32] + l * 64 + l15 * 4), gkn = *(const f32x4*)(p.in[33] + l * 64 + l15 * 4);
    constexpr int TPB = TT / PT;
    const int nx3_ = (NB * TPB) % (int)gridDim.x, nA_ = (int)gridDim.x > nx3_ ? (int)gridDim.x - nx3_ : (int)gridDim.x;
    for (int tile = nA_ - 1 - (int)blockIdx.x; tile >= 0 && tile < NB * TPB; tile += nA_) {
        const int b = tile / TPB, t0 = (tile - b * TPB) * PT, tw = t0 + wave * 4;
        {
            u32x2 nq[4], nk[4], nv[4], gq[4], gk[4], gv[4];
#pragma unroll
            for (int q = 0; q < 4; ++q) {
                const bf16_t* u = U + (size_t)(b * TT + tw + q) * NINP;
                nq[q] = *(const u32x2*)(u + C_NA + lane * 4); nk[q] = *(const u32x2*)(u + C_NA + 256 + lane * 4); nv[q] = *(const u32x2*)(u + C_NA + 512 + lane * 4);
                gq[q] = *(const u32x2*)(u + C_GQ + lane * 4); gk[q] = *(const u32x2*)(u + C_GQ + 256 + (lane & 31) * 4); gv[q] = *(const u32x2*)(u + C_GQ + 384 + (lane & 31) * 4);
            }
#pragma unroll
            for (int qi = 0; qi < 4; ++qi) {
                const int tl = wave * 4 + qi, t = t0 + tl, g = b * TT + t;
                {
                    f32x4 q = unpack4(nq[qi]), k = unpack4(nk[qi]);
                    const float sq = red16(q[0] * q[0] + q[1] * q[1] + q[2] * q[2] + q[3] * q[3]), sk = red16(k[0] * k[0] + k[1] * k[1] + k[2] * k[2] + k[3] * k[3]);
                    const float rq = rsqrtf(sq * (1.f / 64) + 1e-6f), rk = rsqrtf(sk * (1.f / 64) + 1e-6f);
                    q = q * rq * nqn; k = k * rk * nkn;
                    *(u32x2*)(QC + (size_t)g * 256 + lane * 4) = pack4(q[0], q[1], q[2], q[3]);
                    *(u32x2*)(KC + (size_t)g * 256 + lane * 4) = pack4(k[0], k[1], k[2], k[3]);
                    lv_put(lvC, lane * 4, tl, nv[qi]);
                }
                {
                    const bool lat = t >= CTX; const int s = t - CTX; const float pos = (float)((lane & 8) ? (s & 63) : (s >> 6));
                    f32x4 q = unpack4(gq[qi]), k = unpack4(gk[qi]);
                    const float sq = red16(q[0] * q[0] + q[1] * q[1] + q[2] * q[2] + q[3] * q[3]), sk = red16(k[0] * k[0] + k[1] * k[1] + k[2] * k[2] + k[3] * k[3]);
                    const float rq = rsqrtf(sq * (1.f / 64) + 1e-6f), rk = rsqrtf(sk * (1.f / 64) + 1e-6f);
                    q = q * rq * gqn; k = k * rk * gkn;
                    f32x4 qo = q, ko = k;
                    const bool isx1 = (lane & 4) == 0;
#pragma unroll
                    for (int j = 0; j < 4; ++j) {
                        const float qp = __shfl_xor(q[j], 4), kp = __shfl_xor(k[j], 4);
                        float cs, sn; rope_tab((lane & 3) * 4 + j, 16, pos, cs, sn);
                        if (lat) { qo[j] = isx1 ? q[j] * cs - qp * sn : qp * sn + q[j] * cs; ko[j] = isx1 ? k[j] * cs - kp * sn : kp * sn + k[j] * cs; }
                    }
                    *(u32x2*)(QD + (size_t)g * 256 + lane * 4) = pack4(qo[0], qo[1], qo[2], qo[3]);
                    if (lane < 32) { *(u32x2*)(KD + (size_t)g * 128 + lane * 4) = pack4(ko[0], ko[1], ko[2], ko[3]); lv_put(lvD, lane * 4, tl, gv[qi]); }
                }
            }
        }
        __syncthreads();
        vt_flush(lvC, (bf16_t*)(p.ws + WS_VTC), 256, b, t0);
        vt_flush(lvD, (bf16_t*)(p.ws + WS_VTD), 128, b, t0);
        __syncthreads();
    }
    {
        for (int i = tid; i < 192 * 64; i += 512) {
            const int j = i >> 6, c4 = (i & 63) * 4;
            const float* src = j < 64 ? w2 + (size_t)j * 256 : (j < 128 ? a2 + (size_t)(j - 64) * 256 : g2 + (size_t)(j - 128) * 256);
            const f32x4 v = *(const f32x4*)(src + c4);
            *(u32x2*)(wl + j * 256 + c4) = pack4(v[0], v[1], v[2], v[3]);
        }
    }
    for (int tile = (int)gridDim.x - 1 - (int)blockIdx.x; tile < NB * TPB; tile += gridDim.x) {
        const int b = tile / TPB, t0 = (tile - b * TPB) * PT, tw = t0 + wave * 4;
        {
#pragma unroll
            for (int q = 0; q < 4; ++q) {
                const int t = tw + q;
                const bool hp = (t != 0) && (t != CTX), hn = (t != CTX - 1) && (t != TT - 1);
                if (lane < 48) {
                    const f32x4 y = rw_shift(U + (size_t)(b * TT + t) * NINP + C_RW, 768 + lane * 4, hp, hn, mu);
#pragma unroll
                    for (int j = 0; j < 4; ++j) { float v = y[j]; if (lane < 16) { const float ex = __expf(2.0f * v); v = 1.0f - 2.0f / (ex + 1.0f); } else if (lane >= 32) v = sigm(v); mylora[(lane * 4 + j) * 4 + q] = v; }
                }
            }
            __syncthreads();
            f32x4 zw[2][4], za[2][4], gg[4];
#pragma unroll
            for (int d = 0; d < 2; ++d) { const f32x4 w0v = *(const f32x4*)(w0 + d * 256 + lane * 4), a0v = *(const f32x4*)(a0 + d * 256 + lane * 4);
#pragma unroll
                for (int q = 0; q < 4; ++q) { zw[d][q] = w0v; za[d][q] = a0v; } }
#pragma unroll
            for (int q = 0; q < 4; ++q) gg[q] = (f32x4){0.f, 0.f, 0.f, 0.f};
#pragma unroll 4
            for (int j = 0; j < 32; ++j) {
#pragma unroll
                for (int d = 0; d < 2; ++d) {
                    const f32x4 ww = ldbf4(wl + (d * 32 + j) * 256 + lane * 4), aw = ldbf4(wl + (64 + d * 32 + j) * 256 + lane * 4);
                    const f32x4 tw4 = *(const f32x4*)(mylora + (d * 32 + j) * 4), ta = *(const f32x4*)(mylora + (64 + d * 32 + j) * 4);
#pragma unroll
                    for (int q = 0; q < 4; ++q) { zw[d][q] += tw4[q] * ww; za[d][q] += ta[q] * aw; }
                }
            }
#pragma unroll 4
            for (int j = 0; j < 64; ++j) {
                const f32x4 gw = ldbf4(wl + (128 + j) * 256 + lane * 4); const f32x4 tg = *(const f32x4*)(mylora + (128 + j) * 4);
#pragma unroll
                for (int q = 0; q < 4; ++q) gg[q] += tg[q] * gw;
            }
            const f32x4 kkv = *(const f32x4*)(k_k + lane * 4), kav = *(const f32x4*)(k_a + lane * 4), rkv = *(const f32x4*)(r_k + lane * 4);
            f32x4 nxr, nxk, nxv;
            { const int t = tw; const bool hp = (t != 0) && (t != CTX), hn = (t != CTX - 1) && (t != TT - 1); const bf16_t* u = U + (size_t)(b * TT + t) * NINP + C_RW;
              nxr = rw_shift(u, lane * 4, hp, hn, mu); nxk = rw_shift(u, 256 + lane * 4, hp, hn, mu); nxv = rw_shift(u, 512 + lane * 4, hp, hn, mu); }
#pragma unroll
            for (int q = 0; q < 4; ++q) {
                const int t = tw + q, g = b * TT + t;
                const f32x4 xrq = nxr, xkq = nxk, xvq = nxv;
                asm volatile("" ::: "memory");
                if (q < 3) { const int t1 = t + 1; const bool hp = (t1 != 0) && (t1 != CTX), hn = (t1 != CTX - 1) && (t1 != TT - 1); const bf16_t* u = U + (size_t)(b * TT + t1) * NINP + C_RW;
                    nxr = rw_shift(u, lane * 4, hp, hn, mu); nxk = rw_shift(u, 256 + lane * 4, hp, hn, mu); nxv = rw_shift(u, 512 + lane * 4, hp, hn, mu); }
                f32x4 kk = xkq * kkv;
                const float ss = red16(kk[0] * kk[0] + kk[1] * kk[1] + kk[2] * kk[2] + kk[3] * kk[3]);
                kk = kk * rsqrtf(ss + 1e-12f);
                const size_t fb = (size_t)g * 1024 + (lane >> 4) * 256 + l15 * 4;
                *(u32x2*)(FS + fb) = pack4(xrq[0], xrq[1], xrq[2], xrq[3]);
                *(u32x2*)(FS + fb + 64) = pack4(xkq[0], xkq[1], xkq[2], xkq[3]);
                *(u32x2*)(FS + fb + 128) = pack4(kk[0], kk[1], kk[2], kk[3]);
                *(u32x2*)(FS + fb + 192) = pack4(xvq[0], xvq[1], xvq[2], xvq[3]);
                float bon = 0.f;
#pragma unroll
                for (int d = 0; d < 2; ++d) {
                    f32x4 e, a;
#pragma unroll
                    for (int j = 0; j < 4; ++j) { e[j] = 0.6065306597126334f * sigm(zw[d][q][j]); a[j] = sigm(za[d][q][j]);
                        const float kd = xkq[j] * (1.0f + (a[j] - 1.0f) * kav[j]); bon += xrq[j] * kd * rkv[j]; }
                    *(u32x2*)(FD + fb + d * 128) = pack4(e[0], e[1], e[2], e[3]);
                    *(u32x2*)(FD + fb + d * 128 + 64) = pack4(a[0], a[1], a[2], a[3]);
                }
                bon = red16(bon);
                if (l15 == 0) BON[(size_t)g * 4 + (lane >> 4)] = bon;
                *(u32x2*)(G + (size_t)g * 256 + lane * 4) = pack4(gg[q][0], gg[q][1], gg[q][2], gg[q][3]);
            }
        }
        __syncthreads();
    }
}
DI void phase_prep2(const P& p, int l, unsigned char* ldsb) {
    const int tid = threadIdx.x + oz(), lane = tid & 63, wave = tid >> 6, l15 = lane & 15, hd = lane >> 4;
    const bf16_t* U = (const bf16_t*)(p.ws + WS_U); const bf16_t* RAW = (const bf16_t*)(p.ws + WS_A);
    bf16_t* QA = (bf16_t*)(p.ws + WS_QA); bf16_t* KA = (bf16_t*)(p.ws + WS_KA);
    bf16_t* lv = (bf16_t*)ldsb;
    const float* qn = p.in[16] + l * 96; const float* kn = p.in[17] + l * 96;
    const f32x4 qn4 = *(const f32x4*)(qn + l15 * 4), kn4 = *(const f32x4*)(kn + l15 * 4);
    const f32x2 qn2 = *(const f32x2*)(qn + 64 + l15 * 2), kn2 = *(const f32x2*)(kn + 64 + l15 * 2);
    constexpr int TPB = TT / PT;
    for (int tile = blockIdx.x; tile < NB * TPB; tile += gridDim.x) {
        const int b = tile / TPB, t0 = (tile - b * TPB) * PT, tw = t0 + wave * 4;
        u32x2 i_uq[4], i_qa[4], i_ka[4], i_va[4]; unsigned i_ukv[4], i_qb[4], i_kb[4];
#pragma unroll
        for (int q = 0; q < 4; ++q) {
            const int t = tw + q; const bf16_t* u = U + (size_t)(b * TT + t) * NINP; const bf16_t* raw = RAW + (size_t)(b * TT + t) * 1024;
            i_uq[q] = *(const u32x2*)(u + lane * 4); i_ukv[q] = *(const unsigned*)(u + 256 + lane * 2); i_kb[q] = *(const unsigned*)(u + 384 + l15 * 2);
            i_qa[q] = *(const u32x2*)(raw + hd * 96 + l15 * 4); i_qb[q] = *(const unsigned*)(raw + hd * 96 + 64 + l15 * 2);
            i_ka[q] = *(const u32x2*)(raw + 384 + hd * 128 + l15 * 4); i_va[q] = *(const u32x2*)(raw + 384 + hd * 128 + 64 + l15 * 4);
        }
#pragma unroll
        for (int qi = 0; qi < 4; ++qi) {
            const int tl = wave * 4 + qi, t = t0 + tl, g = b * TT + t;
            const f32x4 uq = unpack4(i_uq[qi]);
            const float sq = red64(uq[0] * uq[0] + uq[1] * uq[1] + uq[2] * uq[2] + uq[3] * uq[3]);
            const f32x2 ukv = {__uint_as_float(i_ukv[qi] << 16), __uint_as_float(i_ukv[qi] & 0xffff0000u)};
            const float skv = red64(ukv[0] * ukv[0] + ukv[1] * ukv[1]);
            const float rq = rsqrtf(sq * (1.f / 256) + 1e-6f), rkv = rsqrtf(skv * (1.f / 128) + 1e-6f);
            f32x4 qa = unpack4(i_qa[qi]) * rq;
            f32x2 qb = {__uint_as_float(i_qb[qi] << 16) * rq, __uint_as_float(i_qb[qi] & 0xffff0000u) * rq};
            f32x4 ka = unpack4(i_ka[qi]) * rkv;
            f32x2 kb = {__uint_as_float(i_kb[qi] << 16), __uint_as_float(i_kb[qi] & 0xffff0000u)};
            const f32x4 va = unpack4(i_va[qi]) * rkv;
            const float ssq = red16(qa[0] * qa[0] + qa[1] * qa[1] + qa[2] * qa[2] + qa[3] * qa[3] + qb[0] * qb[0] + qb[1] * qb[1]);
            const float ssk = red16(ka[0] * ka[0] + ka[1] * ka[1] + ka[2] * ka[2] + ka[3] * ka[3] + kb[0] * kb[0] + kb[1] * kb[1]);
            const float r1 = rsqrtf(ssq * (1.f / 96) + 1e-6f), r2 = rsqrtf(ssk * (1.f / 96) + 1e-6f);
            qa = qa * r1 * qn4; qb = qb * r1 * qn2; ka = ka * r2 * kn4; kb = kb * r2 * kn2;
            const bool lat = t >= CTX; const int s = t - CTX; const float pos = (float)((lane & 8) ? (s & 63) : (s >> 6));
            f32x2 qo = qb, ko = kb; const bool isx1 = (lane & 4) == 0;
#pragma unroll
            for (int j = 0; j < 2; ++j) {
                const float qp = __shfl_xor(qb[j], 4), kp = __shfl_xor(kb[j], 4);
                float cs, sn; rope_tab((lane & 3) * 2 + j, 8, pos, cs, sn);
                if (lat) { qo[j] = isx1 ? qb[j] * cs - qp * sn : qp * sn + qb[j] * cs; ko[j] = isx1 ? kb[j] * cs - kp * sn : kp * sn + kb[j] * cs; }
            }
            *(u32x2*)(QA + (size_t)g * 384 + hd * 96 + l15 * 4) = pack4(qa[0], qa[1], qa[2], qa[3]);
            *(unsigned*)(QA + (size_t)g * 384 + hd * 96 + 64 + l15 * 2) = pack2(qo[0], qo[1]);
            *(u32x2*)(KA + (size_t)g * 384 + hd * 96 + l15 * 4) = pack4(ka[0], ka[1], ka[2], ka[3]);
            *(unsigned*)(KA + (size_t)g * 384 + hd * 96 + 64 + l15 * 2) = pack2(ko[0], ko[1]);
            lv_put(lv, lane * 4, tl, pack4(va[0], va[1], va[2], va[3]));
        }
        __syncthreads();
        vt_flush(lv, (bf16_t*)(p.ws + WS_VTA), 256, b, t0);
        __syncthreads();
    }
}

#define MFMA32(a, b, c) __builtin_amdgcn_mfma_f32_32x32x16_bf16((a), (b), (c), 0, 0, 0)
DI bf16x8 pack8(const f32x16& x, int s) {
    u32x4 w; w.x = pack2(x[8 * s + 0], x[8 * s + 1]); w.y = pack2(x[8 * s + 2], x[8 * s + 3]); w.z = pack2(x[8 * s + 4], x[8 * s + 5]); w.w = pack2(x[8 * s + 6], x[8 * s + 7]);
    return __builtin_bit_cast(bf16x8, w);
}
DI bf16x8 ldv8(const bf16_t* p) { const s16x4 lo = *(const s16x4*)p, hi = *(const s16x4*)(p + 8); return __builtin_shufflevector(lo, hi, 0, 1, 2, 3, 4, 5, 6, 7); }
struct AttState { f32x16 o0, o1; float m, l; };
DI void attn_update(AttState& st, f32x16& t, const bf16_t* vt  ) {
    float mx = t[0];
#pragma unroll
    for (int i = 1; i < 16; ++i) mx = fmaxf(mx, t[i]);
    mx = fmaxf(mx, __shfl_xor(mx, 32));
    const float mn = fmaxf(st.m, mx), alpha = __builtin_amdgcn_exp2f(st.m - mn);
    float ps = 0.f;
#pragma unroll
    for (int i = 0; i < 16; ++i) { t[i] = __builtin_amdgcn_exp2f(t[i] - mn); ps += t[i]; }
    st.l = st.l * alpha + ps; st.m = mn;
    st.o0 *= alpha; st.o1 *= alpha;
    const bf16x8 p0 = pack8(t, 0), p1 = pack8(t, 1);
    st.o0 = MFMA32(ldv8(vt), p0, st.o0); st.o0 = MFMA32(ldv8(vt + 16), p1, st.o0);
    st.o1 = MFMA32(ldv8(vt + (size_t)32 * TT), p0, st.o1); st.o1 = MFMA32(ldv8(vt + (size_t)32 * TT + 16), p1, st.o1);
}
DI void attn_store(AttState& st, bf16_t* orow  , int hh) {
    const float l = st.l + __shfl_xor(st.l, 32), inv = 1.0f / l;
#pragma unroll
    for (int g4 = 0; g4 < 4; ++g4) {
        *(u32x2*)(orow + 8 * g4 + 4 * hh) = pack4(st.o0[4 * g4] * inv, st.o0[4 * g4 + 1] * inv, st.o0[4 * g4 + 2] * inv, st.o0[4 * g4 + 3] * inv);
        *(u32x2*)(orow + 32 + 8 * g4 + 4 * hh) = pack4(st.o1[4 * g4] * inv, st.o1[4 * g4 + 1] * inv, st.o1[4 * g4 + 2] * inv, st.o1[4 * g4 + 3] * inv);
    }
}
template <int DQ>
DI void attn_dense_wave(const bf16_t* Qp, int qstride, const bf16_t* Kp, int kstride, const bf16_t* Vt, int nkeys, float sc_log2, bf16_t* Op, int lane) {
    const int r = lane & 31, hh = lane >> 5;
    bf16x8 qf[DQ / 16];
#pragma unroll
    for (int s = 0; s < DQ / 16; ++s) qf[s] = *(const bf16x8*)(Qp + (size_t)r * qstride + s * 16 + hh * 8);
    AttState st;
#pragma unroll
    for (int i = 0; i < 16; ++i) { st.o0[i] = 0.f; st.o1[i] = 0.f; }
    st.m = -1e30f; st.l = 0.f;
    const bf16_t* kp = Kp + (size_t)r * kstride + hh * 8;
    const bf16_t* vp = Vt + (size_t)r * TT + 4 * hh;
#pragma unroll 1
    for (int kt = 0; kt < nkeys; kt += 32) {
        f32x16 s;
#pragma unroll
        for (int i = 0; i < 16; ++i) s[i] = 0.f;
#pragma unroll
        for (int st2 = 0; st2 < DQ / 16; ++st2) s = MFMA32(*(const bf16x8*)(kp + (size_t)kt * kstride + st2 * 16), qf[st2], s);
#pragma unroll
        for (int i = 0; i < 16; ++i) s[i] *= sc_log2;
        attn_update(st, s, vp + kt);
    }
    attn_store(st, Op + (size_t)r * 1024, hh);
}

template <int DQ>
DI void attn_block(const bf16_t* Qw, int qstride, const bf16_t* Kg, int kstride, const bf16_t* Vtg, int nkeys, float sc_log2, bf16_t* Ow, LAS unsigned char* lds, int tid) {
    constexpr int KST = DQ * 2 + 16, VST = 144, KBYTES = 64 * KST, VBYTES = 64 * VST, STAGE = KBYTES + VBYTES;
    constexpr int KPC = 64 * DQ / 8, VPC = 512, NI = (KPC + VPC + 511) / 512, CPR = DQ / 8;
    const int lane = tid & 63, r = lane & 31, hh = lane >> 5;
    bf16x8 qf[DQ / 16];
#pragma unroll
    for (int s = 0; s < DQ / 16; ++s) qf[s] = *(const bf16x8*)(Qw + (size_t)r * qstride + s * 16 + hh * 8);
#pragma unroll
    for (int s = 0; s < DQ / 16; ++s) asm volatile("" :: "v"(qf[s]));
    f32x16 o0, o1;
#pragma unroll
    for (int i = 0; i < 16; ++i) { o0[i] = 0.f; o1[i] = 0.f; }
    float m = -1e30f, l = 0.f;
    u32x4 sA[NI], sB[NI];
    const bf16_t* gsrc[NI]; int ldst[NI]; int kind[NI]; int gstep[NI];
#pragma unroll
    for (int i = 0; i < NI; ++i) {
        const int pid = tid + 512 * i;
        if (pid < KPC) { const int key = pid / CPR, c8 = pid % CPR; gsrc[i] = Kg + (size_t)key * kstride + c8 * 8; ldst[i] = key * KST + c8 * 16; kind[i] = 0; gstep[i] = 64 * kstride; }
        else if (pid < KPC + VPC) { const int pv = pid - KPC, dv = pv >> 3, c8 = pv & 7; gsrc[i] = Vtg + (size_t)dv * TT + c8 * 8; ldst[i] = KBYTES + dv * VST + (c8 >> 1) * 32 + (c8 & 1) * 8; kind[i] = 1; gstep[i] = 64; }
        else { gsrc[i] = Kg; ldst[i] = 0; kind[i] = 2; gstep[i] = 0; }
    }
    const int nt = nkeys / 64;
#define AT_GLOAD(SET, jt) do { if ((jt) < nt) { _Pragma("unroll") for (int i = 0; i < NI; ++i) if (kind[i] != 2) SET[i] = *(const u32x4*)(gsrc[i] + (size_t)(jt) * gstep[i]); } } while (0)
#define AT_LSTORE(SET, jt) do { if ((jt) < nt) { LAS unsigned char* nb_ = lds + ((jt) & 1) * STAGE; _Pragma("unroll") for (int i = 0; i < NI; ++i) { \
        if (kind[i] == 0) *(LAS u32x4*)(nb_ + ldst[i]) = SET[i]; \
        else if (kind[i] == 1) { *(LAS u32x2*)(nb_ + ldst[i]) = (u32x2){SET[i].x, SET[i].y}; *(LAS u32x2*)(nb_ + ldst[i] + 16) = (u32x2){SET[i].z, SET[i].w}; } } } } while (0)
#define AT_COMPUTE(jt) do { \
        LAS unsigned char* kb_ = lds + ((jt) & 1) * STAGE; LAS unsigned char* vb_ = kb_ + KBYTES; \
        f32x16 s0, s1; \
        _Pragma("unroll") for (int i = 0; i < 16; ++i) { s0[i] = 0.f; s1[i] = 0.f; } \
        _Pragma("unroll") for (int s = 0; s < DQ / 16; ++s) { \
            const bf16x8 a0 = *(const LAS bf16x8*)(kb_ + r * KST + s * 32 + hh * 16), a1 = *(const LAS bf16x8*)(kb_ + (32 + r) * KST + s * 32 + hh * 16); \
            s0 = MFMA32(a0, qf[s], s0); s1 = MFMA32(a1, qf[s], s1); } \
        s0 = s0 * sc_log2; s1 = s1 * sc_log2; \
        float mx = fmaxf(s0[0], s1[0]); \
        _Pragma("unroll") for (int i = 1; i < 16; ++i) mx = fmaxf(mx, fmaxf(s0[i], s1[i])); \
        { auto rr_ = __builtin_amdgcn_permlane32_swap(__float_as_uint(mx), __float_as_uint(mx), false, false); mx = fmaxf(__uint_as_float(rr_[0]), __uint_as_float(rr_[1])); } \
        const float mn = fmaxf(m, mx), alpha = __builtin_amdgcn_exp2f(m - mn); \
        m = mn; \
        const f32x2 nmn2 = {-mn, -mn}; f32x2 ps2 = {0.f, 0.f}; \
        _Pragma("unroll") for (int i = 0; i < 8; ++i) { \
            f32x2 ta = {s0[2 * i], s0[2 * i + 1]}, tb = {s1[2 * i], s1[2 * i + 1]}; ta = ta + nmn2; tb = tb + nmn2; \
            ta[0] = __builtin_amdgcn_exp2f(ta[0]); ta[1] = __builtin_amdgcn_exp2f(ta[1]); tb[0] = __builtin_amdgcn_exp2f(tb[0]); tb[1] = __builtin_amdgcn_exp2f(tb[1]); \
            ps2 = ps2 + ta; ps2 = ps2 + tb; s0[2 * i] = ta[0]; s0[2 * i + 1] = ta[1]; s1[2 * i] = tb[0]; s1[2 * i + 1] = tb[1]; } \
        l = l * alpha + (ps2[0] + ps2[1]); \
        if (__builtin_amdgcn_ballot_w64(alpha != 1.0f) != 0ull) { o0 *= alpha; o1 *= alpha; } \
        const bf16x8 p00 = pack8(s0, 0), p01 = pack8(s0, 1), p10 = pack8(s1, 0), p11 = pack8(s1, 1); \
        _Pragma("unroll") for (int dvb = 0; dvb < 2; ++dvb) { \
            LAS unsigned char* vbase = vb_ + (dvb * 32 + r) * VST + hh * 16; \
            f32x16 o = dvb ? o1 : o0; \
            _Pragma("unroll") for (int q = 0; q < 4; ++q) { \
                const bf16x8 v = *(const LAS bf16x8*)(vbase + q * 32); \
                o = MFMA32(v, q == 0 ? p00 : (q == 1 ? p01 : (q == 2 ? p10 : p11)), o); } \
            if (dvb) o1 = o; else o0 = o; } } while (0)
    AT_GLOAD(sA, 0); AT_LSTORE(sA, 0);
    AT_GLOAD(sB, 1); AT_GLOAD(sA, 2);
    lds_barrier();
#pragma unroll 1
    for (int j = 0; j < nt; j += 2) {
        AT_COMPUTE(j);
        AT_LSTORE(sB, j + 1); AT_GLOAD(sB, j + 3);
        lds_barrier();
        AT_COMPUTE(j + 1);
        AT_LSTORE(sA, j + 2); AT_GLOAD(sA, j + 4);
        lds_barrier();
    }
#undef AT_GLOAD
#undef AT_LSTORE
#undef AT_COMPUTE
    AttState st; st.o0 = o0; st.o1 = o1; st.m = m; st.l = l;
    attn_store(st, Ow + (size_t)r * 1024, hh);
}
DI void attn_na_wave(const P& p, int l, int b, int h, int gr, int hf, int lane) {
    const int r = lane & 31, hh = lane >> 5;
    const bf16_t* QC = (const bf16_t*)(p.ws + WS_QC); const bf16_t* KC = (const bf16_t*)(p.ws + WS_KC); const bf16_t* VT = (const bf16_t*)(p.ws + WS_VTC) + (size_t)(b * 4 + h) * 64 * TT;
    const float* rpb = p.in[31] + (size_t)(l * 4 + h) * 15 * 31;
    const int c = hf * 32 + r, tq = CTX + gr * 64 + c; const size_t gq = (size_t)b * TT + tq;
    const float sc_log2 = 0.125f * 1.4426950408889634f;
    bf16x8 qf[4];
#pragma unroll
    for (int s = 0; s < 4; ++s) qf[s] = *(const bf16x8*)(QC + gq * 256 + h * 64 + s * 16 + hh * 8);
    AttState st;
#pragma unroll
    for (int i = 0; i < 16; ++i) { st.o0[i] = 0.f; st.o1[i] = 0.f; }
    st.m = -1e30f; st.l = 0.f;
    const bf16_t* kbase = KC + ((size_t)b * TT + r) * 256 + h * 64 + hh * 8;
    const bf16_t* vp = VT + (size_t)r * TT + 4 * hh;
#pragma unroll 1
    for (int kt = 0; kt < CTX; kt += 32) {
        f32x16 s;
#pragma unroll
        for (int i = 0; i < 16; ++i) s[i] = 0.f;
#pragma unroll
        for (int s2 = 0; s2 < 4; ++s2) s = MFMA32(*(const bf16x8*)(kbase + (size_t)kt * 256 + s2 * 16), qf[s2], s);
#pragma unroll
        for (int i = 0; i < 16; ++i) s[i] *= sc_log2;
        attn_update(st, s, vp + kt);
    }
    int r0 = gr - 4; r0 = r0 < 0 ? 0 : (r0 > 120 ? 120 : r0);
    int c0 = c - 8; c0 = c0 < 0 ? 0 : (c0 > 48 ? 48 : c0);
#pragma unroll 1
    for (int wt = 0; wt < 16; ++wt) {
        const int wi = wt >> 1, ct = wt & 1, key0 = CTX + (r0 + wi) * 64 + ct * 32;
        f32x16 s;
#pragma unroll
        for (int i = 0; i < 16; ++i) s[i] = 0.f;
#pragma unroll
        for (int s2 = 0; s2 < 4; ++s2) s = MFMA32(*(const bf16x8*)(kbase + (size_t)key0 * 256 + s2 * 16), qf[s2], s);
        const float* brow = rpb + (r0 + wi - gr + 7) * 31;
#pragma unroll
        for (int i = 0; i < 16; ++i) {
            const int j = ct * 32 + (i & 3) + 8 * (i >> 2) + 4 * hh;
            const bool ok = (j >= c0) && (j < c0 + 16);
            const int bi = ok ? (j - c + 15) : 0;
            s[i] = ok ? (s[i] * sc_log2 + brow[bi] * 1.4426950408889634f) : -1e30f;
        }
        attn_update(st, s, vp + key0);
    }
    attn_store(st, (bf16_t*)(p.ws + WS_A) + gq * 1024 + 512 + h * 64, hh);
}

constexpr int SCH = 32;
DI int scan_tok(int n, int dir) { return dir == 0 ? n : (n < CTX ? CTX - 1 - n : TT - 1 - (n - CTX)); }
struct FReg { u32x2 r, k, kk, v, e, a; };
DI void fill_load(FReg (&R)[2], const P& p, int b, int h, int dir, int chunk, int lt) {
    const bf16_t* FS = (const bf16_t*)(p.ws + WS_FS); const bf16_t* FD = (const bf16_t*)(p.ws + WS_FD);
    const int ch = (lt & 15) * 4;
#pragma unroll
    for (int i = 0; i < 2; ++i) {
        const int s = (lt >> 4) + 16 * i, t = scan_tok(chunk * SCH + s, dir); const size_t fb = ((size_t)(b * TT + t) * 4 + h) * 256 + ch;
        R[i].r = *(const u32x2*)(FS + fb); R[i].k = *(const u32x2*)(FS + fb + 64); R[i].kk = *(const u32x2*)(FS + fb + 128); R[i].v = *(const u32x2*)(FS + fb + 192);
        R[i].e = *(const u32x2*)(FD + fb + dir * 128); R[i].a = *(const u32x2*)(FD + fb + dir * 128 + 64);
    }
}
constexpr int SST = 400;
DI void fill_store(const FReg (&R)[2], float* buf, int lt, const f32x4 kav) {
    const int ch = (lt & 15) * 4;
#pragma unroll
    for (int i = 0; i < 2; ++i) {
        const int s = (lt >> 4) + 16 * i; float* o = buf + s * SST + ch;
        const f32x4 r = unpack4(R[i].r), k = unpack4(R[i].k), kk = unpack4(R[i].kk), v = unpack4(R[i].v), e = unpack4(R[i].e), a = unpack4(R[i].a);
        f32x4 w;
#pragma unroll
        for (int j = 0; j < 4; ++j) w[j] = __expf(-e[j]);
        const f32x4 ka = kk * a, kd = k * (1.0f + (a - 1.0f) * kav);
        *(f32x4*)(o) = w; *(f32x4*)(o + 64) = kk; *(f32x4*)(o + 128) = -ka; *(f32x4*)(o + 192) = kd; *(f32x4*)(o + 256) = w * r; *(f32x4*)(o + 320) = v;
        const float c1 = red16(kd[0] * r[0] + kd[1] * r[1] + kd[2] * r[2] + kd[3] * r[3]), c2 = red16(ka[0] * r[0] + ka[1] * r[1] + ka[2] * r[2] + ka[3] * r[3]);
        if ((lt & 15) == 0) *(f32x2*)(buf + s * SST + 384) = (f32x2){c1, c2};
    }
}
struct SIn { f32x4 w, kk, nka, kd, wr; float v; f32x2 c; };
DI SIn scan_ld(const float* sb, int c, int row) {
    SIn x; x.w = *(const f32x4*)(sb + 4 * c); x.kk = *(const f32x4*)(sb + 64 + 4 * c); x.nka = *(const f32x4*)(sb + 128 + 4 * c); x.kd = *(const f32x4*)(sb + 192 + 4 * c); x.wr = *(const f32x4*)(sb + 256 + 4 * c);
    x.v = sb[320 + row]; x.c = *(const f32x2*)(sb + 384);
    return x;
}
DI void scan_unit(const P& p, int l, int unit, float* lbuf) {
    const int tid = threadIdx.x + oz(), lane = tid & 63, wave = tid >> 6;
    const int q4 = unit & 3, dir = (unit >> 2) & 1, h = (unit >> 3) & 3, b = unit >> 5;
    float* Y = (float*)(p.ws + (dir ? WS_YB : WS_YF)) + (size_t)b * TT * 256 + h * 64;
    const bool scanner = wave < 4;
    const int c = lane & 15, row = q4 * 16 + (wave & 3) * 4 + (lane >> 4);
    f32x2 Sa = {0.f, 0.f}, Sb = {0.f, 0.f};
    FReg R[2];
    const f32x4 kav = *(const f32x4*)(p.in[25] + l * 256 + h * 64 + (lane & 15) * 4);
    if (!scanner) { fill_load(R, p, b, h, dir, 0, tid - 256); fill_store(R, lbuf, tid - 256, kav); fill_load(R, p, b, h, dir, 1, tid - 256); }
    lds_barrier();
    constexpr int NCH = TT / SCH;
#pragma unroll 1
    for (int ck = 0; ck < NCH; ++ck) {
        float* cur = lbuf + (ck & 1) * (SCH * SST);
        if (!scanner) {
            if (ck + 1 < NCH) fill_store(R, lbuf + ((ck + 1) & 1) * (SCH * SST), tid - 256, kav);
            if (ck + 2 < NCH) fill_load(R, p, b, h, dir, ck + 2, tid - 256);
        }
        else {
            const int n0 = ck * SCH;
            const int tb = dir == 0 ? n0 : ((n0 < CTX ? CTX - 1 : TT + CTX - 1) - n0), sg = dir == 0 ? 1 : -1;
            SIn i0 = scan_ld(cur, c, row), i1 = scan_ld(cur + SST, c, row), i2 = scan_ld(cur + 2 * SST, c, row);
            float ykeep = 0.f;
#pragma unroll
            for (int s = 0; s < SCH; ++s) {
                const SIn x = (s % 3 == 0) ? i0 : ((s % 3 == 1) ? i1 : i2);
                if (s + 3 < SCH) { const SIn nx = scan_ld(cur + (s + 3) * SST, c, row); if (s % 3 == 0) i0 = nx; else if (s % 3 == 1) i1 = nx; else i2 = nx; }
                f32x2 pa = Sa * (f32x2){x.kk[0], x.kk[1]}; pa = Sb * (f32x2){x.kk[2], x.kk[3]} + pa;
                f32x2 pq = Sa * (f32x2){x.wr[0], x.wr[1]}; pq = Sb * (f32x2){x.wr[2], x.wr[3]} + pq;
                float sa = pa[0] + pa[1], yq = pq[0] + pq[1];
                sa = dpp_add<0xB1>(sa); yq = dpp_add<0xB1>(yq); sa = dpp_add<0x4E>(sa); yq = dpp_add<0x4E>(yq);
                sa = dpp_add<0x141>(sa); yq = dpp_add<0x141>(yq); sa = dpp_add<0x140>(sa); yq = dpp_add<0x140>(yq);
                const f32x2 vv = {x.v, x.v}, sv = {sa, sa};
                Sa = Sa * (f32x2){x.w[0], x.w[1]} + vv * (f32x2){x.kd[0], x.kd[1]}; Sb = Sb * (f32x2){x.w[2], x.w[3]} + vv * (f32x2){x.kd[2], x.kd[3]};
                Sa = sv * (f32x2){x.nka[0], x.nka[1]} + Sa; Sb = sv * (f32x2){x.nka[2], x.nka[3]} + Sb;
                const float y = (yq + x.v * x.c[0]) - sa * x.c[1];
                ykeep = (c == (s & 15)) ? y : ykeep;
                if ((s & 15) == 15) { const int t = tb + sg * (s - 15 + c); Y[(size_t)t * 256 + row] = ykeep; }
            }
        }
        lds_barrier();
    }
}
DI void phase_rwkv_out(const P& p, int l) {
    const int tid_ = threadIdx.x + oz(), lane = tid_ & 63, wave = tid_ >> 6, l15 = lane & 15, hd = lane >> 4;
    const float* YF = (const float*)(p.ws + WS_YF); const float* YB = (const float*)(p.ws + WS_YB);
    const bf16_t* FS = (const bf16_t*)(p.ws + WS_FS); const bf16_t* G = (const bf16_t*)(p.ws + WS_G); const float* BON = (const float*)(p.ws + WS_BON);
    bf16_t* O = (bf16_t*)(p.ws + WS_A);
    const f32x4 lg = *(const f32x4*)(p.in[27] + l * 256 + lane * 4), lb = *(const f32x4*)(p.in[28] + l * 256 + lane * 4);
    for (int g0 = (blockIdx.x * 8 + wave) * 2; g0 < MT; g0 += gridDim.x * 16) {
        f32x4 yv[2], vv[2], gv2[2]; float bo[2];
#pragma unroll
        for (int rr = 0; rr < 2; ++rr) { const int g = g0 + rr;
            yv[rr] = *(const f32x4*)(YF + (size_t)g * 256 + lane * 4) + *(const f32x4*)(YB + (size_t)g * 256 + lane * 4);
            vv[rr] = ldbf4(FS + (size_t)g * 1024 + hd * 256 + 192 + l15 * 4); gv2[rr] = ldbf4(G + (size_t)g * 256 + lane * 4); bo[rr] = BON[(size_t)g * 4 + hd]; }
#pragma unroll
        for (int rr = 0; rr < 2; ++rr) { const int g = g0 + rr;
            const f32x4 y = yv[rr];
            const float mu = red16(y[0] + y[1] + y[2] + y[3]) * (1.f / 64);
            const f32x4 d = y - mu;
            const float var = red16(d[0] * d[0] + d[1] * d[1] + d[2] * d[2] + d[3] * d[3]) * (1.f / 64);
            const float rs = rsqrtf(var + 64e-5f);
            const f32x4 o = (d * rs * lg + lb + bo[rr] * vv[rr]) * gv2[rr];
            *(u32x2*)(O + (size_t)g * 1024 + 256 + lane * 4) = pack4(o[0], o[1], o[2], o[3]);
        }
    }
}

constexpr int IT_SCAN = 64, IT_MLA = 2 * 4 * 33, IT_GQA = 2 * 2 * 66, IT_NA = 2 * 4 * 32, IT_NAC = 8;
constexpr int IT_TOTAL = IT_SCAN + IT_MLA + IT_GQA + IT_NA + IT_NAC;
DI void phase_mixers(const P& p, int l, unsigned char* ldsb, unsigned* counter) {
    volatile int* slot = (volatile int*)(ldsb + LDS_MAIN);
    for (;;) {
        const int tid = threadIdx.x + oz(), lane = tid & 63, wave = tid >> 6;
        bf16_t* OM = (bf16_t*)(p.ws + WS_A) + oz();
        __syncthreads();
        if (tid == 0) *slot = (int)atomicAdd(counter, 1u);
        __syncthreads();
        int item = *slot;
        if (item >= IT_TOTAL) break;
        if (item < IT_SCAN) { scan_unit(p, l, item, (float*)ldsb); continue; }
        item -= IT_SCAN;
        if (item < IT_MLA) {
            const int qb = 32 - (item / 8), bh = item % 8, b = bh >> 2, h = bh & 3;
            const int q0 = qb * 256 + wave * 32; const size_t g0 = (size_t)b * TT + q0;
            attn_block<96>((const bf16_t*)(p.ws + WS_QA) + g0 * 384 + h * 96, 384, (const bf16_t*)(p.ws + WS_KA) + (size_t)b * TT * 384 + h * 96, 384,
                           (const bf16_t*)(p.ws + WS_VTA) + (size_t)(b * 4 + h) * 64 * TT, qb == 0 ? CTX : TT, 0.10206207261596577f * 1.4426950408889634f, OM + g0 * 1024 + h * 64, (LAS unsigned char*)ldsb, tid);
            continue;
        }
        item -= IT_MLA;
        if (item < IT_GQA) {
            const int jq = 65 - (item / 4), bk = item % 4, b = bk >> 1, hk = bk & 1, h = hk * 2 + (wave >> 2);
            const int q0 = jq * 128 + (wave & 3) * 32; const size_t g0 = (size_t)b * TT + q0;
            attn_block<64>((const bf16_t*)(p.ws + WS_QD) + g0 * 256 + h * 64, 256, (const bf16_t*)(p.ws + WS_KD) + (size_t)b * TT * 128 + hk * 64, 128,
                           (const bf16_t*)(p.ws + WS_VTD) + (size_t)(b * 2 + hk) * 64 * TT, jq < 2 ? CTX : TT, 0.125f * 1.4426950408889634f, OM + g0 * 1024 + 768 + h * 64, (LAS unsigned char*)ldsb, tid);
            continue;
        }
        item -= IT_GQA;
        if (item < IT_NA) {
            const int bh = item % 8, rb = item / 8, b = bh >> 2, h = bh & 3;
            attn_na_wave(p, l, b, h, rb * 4 + (wave >> 1), wave & 1, lane);
            continue;
        }
        item -= IT_NA;
        {
            const int b = item >> 2, h = item & 3; const size_t g0 = (size_t)b * TT + wave * 32;
            attn_dense_wave<64>((const bf16_t*)(p.ws + WS_QC) + g0 * 256 + h * 64, 256, (const bf16_t*)(p.ws + WS_KC) + (size_t)b * TT * 256 + h * 64, 256,
                                (const bf16_t*)(p.ws + WS_VTC) + (size_t)(b * 4 + h) * 64 * TT, CTX, 0.125f * 1.4426950408889634f, OM + g0 * 1024 + 512 + h * 64, lane);
        }
    }
}

__global__ void __launch_bounds__(512) mega(P p) {
    extern __shared__ __attribute__((aligned(16))) unsigned char lds[];
    cg::grid_group grid = cg::this_grid();
    LAS unsigned char* ldsl = (LAS unsigned char*)lds;
    const int G = gridDim.x, bx = blockIdx.x;
    unsigned* ctl = (unsigned*)(p.ws + WS_CTL);
    XBar XB; XB.bar = ctl; XB.x = xb_xcc_id(); XB.epoch = 0;
    if (threadIdx.x == 0) ((volatile unsigned*)(lds + LDS_MAIN))[8] = xb_add(ctl + XB_XCNT(XB.x));

#ifndef NO_PHASE_MOD
{ const f32x4* c4 = (const f32x4*)p.in[2]; f32x4* h4 = (f32x4*)(p.ws + WS_HC); for (size_t i = (size_t)bx * 512 + threadIdx.x; i < (size_t)NB * CTX * DM / 4; i += (size_t)G * 512) h4[i] = c4[i]; }
phase_mod(p, (float*)lds);
#endif


    __syncthreads();

#ifndef NO_PHASE_WEIGHTS
phase_weights(p, 0, 0, (float*)lds);
#endif

    asm volatile("s_waitcnt vmcnt(0)" ::: "memory");
    __syncthreads();
    if (threadIdx.x == 0) {
        __builtin_amdgcn_fence(__ATOMIC_RELEASE, "agent");
        asm volatile("s_waitcnt vmcnt(0)" ::: "memory");
        xb_add(ctl + XB_FLAT);
        while (xb_ld(ctl + XB_FLAT) < (unsigned)G) __builtin_amdgcn_s_sleep(1);
        __builtin_amdgcn_fence(__ATOMIC_ACQUIRE, "agent");
        asm volatile("s_waitcnt vmcnt(0)" ::: "memory");
    }
    __syncthreads();
    if (p.ws == nullptr) grid.sync();
    { unsigned nx = 0; for (int j = 0; j < 16; ++j) nx += xb_ld(ctl + XB_XCNT(j)) != 0u; XB.nx = (unsigned)__builtin_amdgcn_readfirstlane((int)nx); XB.nloc = (unsigned)__builtin_amdgcn_readfirstlane((int)xb_ld(ctl + XB_XCNT(XB.x))); }
    int vbx = bx;
    { bool even = (XB.nx == 8u) && (G % 8 == 0);
      for (int j = 0; j < 8; ++j) even = even && (xb_ld(ctl + XB_XCNT(j)) == (unsigned)(G / 8));
      const unsigned rank = ((volatile unsigned*)(lds + LDS_MAIN))[8];
      if (even) vbx = __builtin_amdgcn_readfirstlane((int)(rank * 8u + XB.x)); }
#pragma unroll 1
    for (int l = 0; l < 2; ++l) {
#pragma unroll 1
        for (int half = 0; half < 2; ++half) {
            phase_norm(p, l, half * 2, (l == 0 && half == 0) ? 1 : 0, ((l == 0 && half == 0) || (l == 1 && half == 1)) ? 0 : (half == 0 ? 8 : 4));
            if (l == 1 && half == 0) { __syncthreads(); phase_weights(p, 1, 0, (float*)lds); }
            grid_bar(XB);
            {
                pg8::Gemm g; g.A = (const bf16_t*)(p.ws + WS_A); g.Bt = (const bf16_t*)(p.ws + WS_WGU); g.M = MT; g.N = 5632; g.K = 1024; g.lda = 1024;
                pg8::StaticOrder so; so.init(g.M, g.N, g.K, G, vbx + oz());
                EpiSwiGLU e; e.hid = (bf16_t*)(p.ws + WS_HID);
                pg8::gemm_phase(ldsl, g, so, e);
            }
            grid_bar(XB);
            {
                pg8::Gemm g; g.A = (const bf16_t*)(p.ws + WS_HID); g.Bt = (const bf16_t*)(p.ws + WS_WD); g.M = MT; g.N = 1024; g.K = DFF; g.lda = DFF;
                pg8::StaticOrder so; so.init(g.M, g.N, g.K, G, vbx + oz(), (l == 1 && half == 1) ? 1 : 2, 8);
                EpiResid e; e.gate0 = modp(p, l, 0, half ? 8 : 2); e.hc = (float*)(p.ws + WS_HC); e.out = p.out; e.hc_src = (l == 0 && half == 0) ? p.in[2] : (const float*)(p.ws + WS_HC); e.out_src = (l == 0 && half == 0) ? p.in[0] : (const float*)p.out; e.slab = (float*)(p.ws + WS_SLAB); e.coef = 0.5f; e.skip_ctx = (l == 1 && half == 1);
                pg8::gemm_phase(ldsl, g, so, e);
            }
            grid_bar(XB);
            if (half == 1) break;
            phase_norm(p, l, 1, 0, 8);
            __syncthreads(); phase_weights(p, l, 1, (float*)lds);
            grid_bar(XB);
            {
                pg8::Gemm g; g.A = (const bf16_t*)(p.ws + WS_A); g.Bt = (const bf16_t*)(p.ws + WS_WIN); g.M = MT; g.N = NINP; g.K = 1024; g.lda = 1024;
                pg8::StaticOrder so; so.init(g.M, g.N, g.K, G, vbx + oz());
                EpiBf e; e.O = (bf16_t*)(p.ws + WS_U); e.ldo = NINP;
                pg8::gemm_phase(ldsl, g, so, e);
            }
            grid_bar(XB);
            {
                pg8::Gemm g; g.A = (const bf16_t*)(p.ws + WS_U); g.Bt = (const bf16_t*)(p.ws + WS_WMLA); g.M = MT; g.N = 1024; g.K = 384; g.lda = NINP;
                pg8::StaticOrder so; so.init(g.M, g.N, g.K, G, vbx + oz());
                EpiBf e; e.O = (bf16_t*)(p.ws + WS_A); e.ldo = 1024;
                pg8::gemm_phase(ldsl, g, so, e);
            }
            __syncthreads();
            phase_prep1(p, l, lds);
            grid_bar(XB);
            phase_prep2(p, l, lds);
            grid_bar(XB);

#ifndef NO_PHASE_MIXERS
phase_mixers(p, l, lds, ctl + l);
#endif

            grid_bar(XB);

#ifndef NO_PHASE_RWKV_OUT
phase_rwkv_out(p, l);
#endif

            grid_bar(XB);
            {
                pg8::Gemm g; g.A = (const bf16_t*)(p.ws + WS_A); g.Bt = (const bf16_t*)(p.ws + WS_WOUT); g.M = MT; g.N = 1024; g.K = 1024; g.lda = 1024;
                pg8::StaticOrder so; so.init(g.M, g.N, g.K, G, vbx + oz(), l == 1 ? 1 : 2);
                EpiResid e; e.gate0 = modp(p, l, 0, 5); e.hc = (float*)(p.ws + WS_HC); e.out = p.out; e.hc_src = (const float*)(p.ws + WS_HC); e.out_src = (const float*)p.out; e.slab = (float*)(p.ws + WS_SLAB); e.coef = 1.0f; e.skip_ctx = (l == 1);
                pg8::gemm_phase(ldsl, g, so, e);
            }
            grid_bar(XB);
        }
    }
}

extern "C" void kernel_launch(void* const* d_in, const int* in_sizes, int n_in,
                              void* d_out, int out_size, void* d_ws, size_t ws_size,
                              hipStream_t stream) {
    static int grid_blocks = 0;
    if (!grid_blocks) {
        int dev = 0, cus = 0, per_cu = 0;
        (void)hipGetDevice(&dev);
        (void)hipDeviceGetAttribute(&cus, hipDeviceAttributeMultiprocessorCount, dev);
        (void)hipFuncSetAttribute((const void*)mega, hipFuncAttributeMaxDynamicSharedMemorySize, LDS_BYTES);
        (void)hipOccupancyMaxActiveBlocksPerMultiprocessor(&per_cu, (const void*)mega, 512, LDS_BYTES);
        if (per_cu < 1) per_cu = 1;
        grid_blocks = cus * per_cu;
        if (ws_size < WS_END2) fprintf(stderr, "workspace too small: %zu < %zu\n", ws_size, (size_t)WS_END2);
    }
    P p{};
    for (int i = 0; i < 37; ++i) p.in[i] = (const float*)d_in[i];
    p.out = (float*)d_out; p.ws = (unsigned char*)d_ws;
    (void)hipMemsetAsync((char*)d_ws + WS_CTL, 0, 16384, stream);
    void* args[] = {&p};
    hipError_t e = hipLaunchCooperativeKernel((void*)mega, dim3(grid_blocks), dim3(512), args, LDS_BYTES, stream);
    if (e != hipSuccess) fprintf(stderr, "cooperative launch failed: %s (grid %d)\n", hipGetErrorString(e), grid_blocks);
}
```

```cpp
#include <hip/hip_runtime.h>
#include <hip/hip_cooperative_groups.h>
#include <cstdio>
namespace cg = cooperative_groups;

#define LAS __attribute__((address_space(3)))
#define DI __device__ __forceinline__
typedef unsigned short bf16_t;
typedef short bf16x8 __attribute__((ext_vector_type(8)));
typedef short s16x4 __attribute__((ext_vector_type(4)));
typedef float f32x4 __attribute__((ext_vector_type(4)));
typedef float f32x2 __attribute__((ext_vector_type(2)));
typedef float f32x16 __attribute__((ext_vector_type(16)));
typedef unsigned u32x4 __attribute__((ext_vector_type(4)));
typedef unsigned u32x2 __attribute__((ext_vector_type(2)));
typedef __bf16 bf2_t __attribute__((ext_vector_type(2)));

constexpr int NB = 2, SEQ = 8192, CTX = 256, TT = CTX + SEQ, MT = NB * TT, DM = 1024, DFF = 2816, NIN = 2656, NINP = 2816;
constexpr int GRIDW = 64;
constexpr int C_MLA = 0, C_RW = 416, C_NA = 1376, C_GQ = 2144;

constexpr size_t al256(size_t x) { return (x + 255) & ~(size_t)255; }
constexpr size_t WS_CTL = 0;
constexpr size_t WS_MOD = 16384;
constexpr size_t WS_HC = al256(WS_MOD + 2 * 3 * 9216 * 4);
constexpr size_t WS_WGU = al256(WS_HC + 512 * 1024 * 4);
constexpr size_t WS_WD = WS_WGU + 1ull * 5632 * 1024 * 2;
constexpr size_t WS_WIN = WS_WD + 1ull * 1024 * 2816 * 2;
constexpr size_t WS_WOUT = WS_WIN + 2816ull * 1024 * 2;
constexpr size_t WS_WMLA = WS_WOUT + 1024ull * 1024 * 2;
constexpr size_t WS_A = WS_WMLA + 1024ull * 384 * 2;
constexpr size_t WS_G = WS_A + (size_t)MT * 1024 * 2;
constexpr size_t WS_BON = WS_G + (size_t)MT * 256 * 2;
constexpr size_t WS_BIG = al256(WS_BON + (size_t)MT * 4 * 4);
constexpr size_t WS_U = WS_BIG;
constexpr size_t WS_YF = WS_BIG, WS_YB = WS_BIG + (size_t)MT * 256 * 4;
constexpr size_t WS_FS = WS_BIG + (size_t)MT * NINP * 2;
constexpr size_t WS_FD = WS_FS + (size_t)MT * 1024 * 2;
constexpr size_t WS_QA = WS_FD + (size_t)MT * 1024 * 2;
constexpr size_t WS_KA = WS_QA + (size_t)MT * 384 * 2;
constexpr size_t WS_VTA = WS_KA + (size_t)MT * 384 * 2;
constexpr size_t WS_QD = WS_VTA + (size_t)MT * 256 * 2;
constexpr size_t WS_KD = WS_QD + (size_t)MT * 256 * 2;
constexpr size_t WS_VTD = WS_KD + (size_t)MT * 128 * 2;
constexpr size_t WS_QC = WS_VTD + (size_t)MT * 128 * 2;
constexpr size_t WS_KC = WS_QC + (size_t)MT * 256 * 2;
constexpr size_t WS_VTC = WS_KC + (size_t)MT * 256 * 2;
constexpr size_t WS_END = WS_VTC + (size_t)MT * 256 * 2;
constexpr size_t WS_SLAB = WS_QA;
constexpr size_t WS_END2 = WS_END;
static_assert(8ull * 512 * 1024 * 4 <= 2 * (size_t)MT * 384 * 2, "slab overlay (QA + KA)");
constexpr size_t WS_HID = WS_BIG;
static_assert(WS_HID + (size_t)MT * DFF * 2 <= WS_FS, "hid overlay");
static_assert(WS_YB + (size_t)MT * 256 * 4 <= WS_FS, "y overlay");

constexpr int LDS_MAIN = 131072;
constexpr int LDS_BYTES = LDS_MAIN + 1024;

struct P { const float* in[37]; float* out; unsigned char* ws; };

DI float bf2f(bf16_t b) { return __uint_as_float(((unsigned)b) << 16); }
DI unsigned pack2(float lo, float hi) { f32x2 v = {lo, hi}; bf2_t b = __builtin_convertvector(v, bf2_t); return __builtin_bit_cast(unsigned, b); }
DI bf16_t f2bf(float x) { return (bf16_t)(pack2(x, 0.f) & 0xffffu); }
DI u32x2 pack4(float a, float b, float c, float d) { u32x2 r; r.x = pack2(a, b); r.y = pack2(c, d); return r; }
DI f32x4 unpack4(u32x2 v) { f32x4 r; r[0] = __uint_as_float(v.x << 16); r[1] = __uint_as_float(v.x & 0xffff0000u); r[2] = __uint_as_float(v.y << 16); r[3] = __uint_as_float(v.y & 0xffff0000u); return r; }
DI f32x4 ldbf4(const bf16_t* p) { return unpack4(*(const u32x2*)p); }
template <int CTRL> DI float dpp_add(float x) { return x + __builtin_bit_cast(float, __builtin_amdgcn_update_dpp(0, __builtin_bit_cast(int, x), CTRL, 0xf, 0xf, true)); }
DI float red16(float x) { x = dpp_add<0xB1>(x); x = dpp_add<0x4E>(x); x = dpp_add<0x141>(x); x = dpp_add<0x140>(x); return x; }
DI float red64(float x) { x = red16(x); x += __shfl_xor(x, 16); x += __shfl_xor(x, 32); return x; }
DI void lds_barrier() { asm volatile("s_waitcnt lgkmcnt(0)" ::: "memory"); __builtin_amdgcn_s_barrier(); asm volatile("" ::: "memory"); }
#define XB_XCNT(j) (256 + 64 * (j))
#define XB_XSUB(j) (1280 + 64 * (j))
#define XB_XGEN(j) (2304 + 64 * (j))
#define XB_TOP 3328
#define XB_TOPGEN 3392
#define XB_FLAT 3456
DI unsigned xb_ld(unsigned* p) { return __hip_atomic_load(p, __ATOMIC_RELAXED, __HIP_MEMORY_SCOPE_AGENT); }
DI unsigned xb_add(unsigned* p) { return __hip_atomic_fetch_add(p, 1u, __ATOMIC_RELAXED, __HIP_MEMORY_SCOPE_AGENT); }
DI unsigned xb_xcc_id() { return (unsigned)__builtin_amdgcn_s_getreg((3 << 11) | 20) & 0xFu; }
struct XBar { unsigned* bar; unsigned x, nloc, nx, epoch; };
DI void grid_bar(XBar& B) {
    asm volatile("s_waitcnt vmcnt(0)" ::: "memory");
    __syncthreads();
    B.epoch += 1;
    if (threadIdx.x == 0) {
        const unsigned e = B.epoch;
        const unsigned a = xb_add(B.bar + XB_XSUB(B.x)) + 1u;
        if (a == e * B.nloc) {
            __builtin_amdgcn_fence(__ATOMIC_RELEASE, "agent");
            asm volatile("s_waitcnt vmcnt(0)" ::: "memory");
            const unsigned t = xb_add(B.bar + XB_TOP) + 1u;
            if (t == e * B.nx) __hip_atomic_store(B.bar + XB_TOPGEN, e, __ATOMIC_RELAXED, __HIP_MEMORY_SCOPE_AGENT);
            else while (xb_ld(B.bar + XB_TOPGEN) < e) __builtin_amdgcn_s_sleep(1);
            __hip_atomic_store(B.bar + XB_XGEN(B.x), e, __ATOMIC_RELAXED, __HIP_MEMORY_SCOPE_AGENT);
        } else while (xb_ld(B.bar + XB_XGEN(B.x)) < e) __builtin_amdgcn_s_sleep(1);
        __builtin_amdgcn_fence(__ATOMIC_ACQUIRE, "agent");
        asm volatile("s_waitcnt vmcnt(0)" ::: "memory");
    }
    __syncthreads();
}
DI int oz() { int z; asm volatile("s_mov_b32 %0, 0" : "=s"(z)); return z; }
DI float sigm(float x) { return __builtin_amdgcn_rcpf(1.0f + __expf(-x)); }
DI float* hrow(const P& p, int g) { const int b = g / TT, t = g - b * TT; return t < CTX ? (float*)(p.ws + WS_HC) + (size_t)(b * CTX + t) * DM : p.out + (size_t)(b * SEQ + t - CTX) * DM; }
DI const float* modp(const P& p, int l, int mrow, int j) { return (const float*)(p.ws + WS_MOD) + (size_t)(l * 3 + mrow) * 9216 + j * 1024; }

namespace pg8 {
constexpr int BM = 256, BK = 64, HALF = 128, HTB = HALF * BK * 2, STAGE_BYTES = 8 * HTB, NXCD = 8, WGM = 8;
DI int lds_byte(int r, int c) { const int st = (r >> 4) * 2 + (c >> 5), rr = r & 15, cc = c & 31, ob = rr * 64 + cc * 2; return st * 1024 + (ob ^ (((ob >> 9) & 1) << 5)); }
DI void stage_rc(int b, int& R, int& C) { const int st = b / 1024, sb = b % 1024, swz = sb ^ (((sb >> 9) & 1) << 5); R = (st >> 1) * 16 + swz / 64; C = (st & 1) * 32 + (swz % 64) / 2; }
DI int perm32(int rho) { const int n = rho >> 4, i = rho & 15; return 8 * (i >> 2) + 4 * n + (i & 3); }
struct Unit { int pm, pn, k0, nt, part; };
struct Gemm { const bf16_t* A; const bf16_t* Bt; int M, N, K, lda; };
struct StaticOrder {
    int nM, nN, nwg, G, c, mode, ntfull, ntot, nsl;
    DI void init(int M, int N, int K, int G_, int c_, int mode_ = 0, int nsl_ = 4) { mode = mode_; nsl = nsl_; nM = M / BM - (mode_ ? 2 : 0); nN = N / BM; nwg = nM * nN; G = G_; c = c_; ntfull = K / BK; ntot = nwg + (mode_ == 2 ? 2 * nN * nsl_ : 0); }
    DI bool next(int i, Unit& u) const {
        const long L = (long)i * G + c; if (L >= ntot) return false;
        const bool part = L >= nwg;
        const int q = part ? (int)L - nwg : 0, cu = q / nsl, ch = q - cu * nsl, base = (ntfull / nsl) & ~1, rem2 = (ntfull - nsl * base) / 2;
        const int ppm = (cu / nN) ? 33 : 0, ppn = cu % nN, pnt = base + (ch < rem2 ? 2 : 0), pk0 = (ch * base + 2 * (ch < rem2 ? ch : rem2)) * BK;
        int wgid = part ? 0 : (int)L; { const int qq = nwg / NXCD, r = nwg % NXCD, xcd = wgid % NXCD, off = wgid / NXCD; wgid = (xcd < r ? xcd * (qq + 1) : r * (qq + 1) + (xcd - r) * qq) + off; }
        const int nig = WGM * nN, gid = wgid / nig, fm = gid * WGM, gsz = (nM - fm) < WGM ? (nM - fm) : WGM;
        int mpm = fm + ((wgid % nig) % gsz); const int mpn = (wgid % nig) / gsz; if (mode) mpm += 1 + (mpm >= 32 ? 1 : 0);
        u.pm = part ? ppm : mpm; u.pn = part ? ppn : mpn; u.k0 = part ? pk0 : 0; u.nt = part ? pnt : ntfull; u.part = __builtin_amdgcn_readfirstlane(part ? ch + 1 : 0);
        return true;
    }
};
template <class Epi>
DI void gemm_phase(LAS unsigned char* lds, const Gemm g, const StaticOrder& S, const Epi& E) {
    const int tid = threadIdx.x + oz(), wid = __builtin_amdgcn_readfirstlane(tid >> 6), lane = tid & 63, wr = wid >> 2, wc = wid & 3, fr = lane & 15, fq = lane >> 4;
    const int K = g.K, lda = g.lda;
    unsigned voffA[2], voffB[2];
#pragma unroll
    for (int i = 0; i < 2; ++i) { int R, C; stage_rc(tid * 16 + i * 8192, R, C); const int Rb = Epi::PERM ? ((R & ~31) + perm32(R & 31)) : R; voffA[i] = (unsigned)(R * lda + C) * 2u; voffB[i] = (unsigned)(Rb * K + C) * 2u; }
    const size_t kstep = (size_t)(BK * 2);
    const size_t hstepA = (size_t)HALF * lda * 2, hstepB = (size_t)HALF * K * 2;
    const size_t tstepA = 2 * hstepA, tstepB = 2 * hstepB;
    const unsigned ldsw = (unsigned)wid * 1024u;
    const int aoff = lds_byte(wr * 64 + fr, fq * 8), boff = lds_byte(wc * 32 + fr, fq * 8);
#define PG8_SA(b, h) (((b) * 2 + (h)) * HTB)
#define PG8_SB(b, h) ((4 + (b) * 2 + (h)) * HTB)
#define PG8_STAGE(bufoff, gbase, voff) do { _Pragma("unroll") for (int _i = 0; _i < 2; ++_i) \
        __builtin_amdgcn_global_load_lds((const unsigned*)((const char*)(gbase) + (voff)[_i]), (LAS unsigned*)(lds + (bufoff) + ldsw + _i * 8192), 16, 0, 0); } while (0)
#define PG8_LDA(dst, b, h) do { _Pragma("unroll") for (int m = 0; m < 4; ++m) _Pragma("unroll") for (int k = 0; k < 2; ++k) dst[m][k] = *(const LAS bf16x8*)(lds + PG8_SA(b, h) + aoff + m * 2048 + k * 1024); } while (0)
#define PG8_LDB(dst, b, h) do { _Pragma("unroll") for (int n = 0; n < 2; ++n) _Pragma("unroll") for (int k = 0; k < 2; ++k) dst[n][k] = *(const LAS bf16x8*)(lds + PG8_SB(b, h) + boff + n * 2048 + k * 1024); } while (0)
#define PG8_MMA(ai, bj, At, Bt) do { __builtin_amdgcn_s_setprio(1); _Pragma("unroll") for (int m = 0; m < 4; ++m) _Pragma("unroll") for (int n = 0; n < 2; ++n) _Pragma("unroll") for (int k = 0; k < 2; ++k) \
        acc[ai][bj][m][n] = __builtin_amdgcn_mfma_f32_16x16x32_bf16(Bt[n][k], At[m][k], acc[ai][bj][m][n], 0, 0, 0); __builtin_amdgcn_s_setprio(0); } while (0)
#define PG8_WAIT_V(n) asm volatile("s_waitcnt vmcnt(" #n ")" ::: "memory")
#define PG8_WAIT_L(n) asm volatile("s_waitcnt lgkmcnt(" #n ")" ::: "memory")
#define PG8_BAR __builtin_amdgcn_s_barrier()
#define PG8_SCHED __builtin_amdgcn_sched_barrier(0)
    Unit cur, nxt; int ui = 0;
    if (!S.next(0, cur)) return;
    f32x4 acc[2][2][4][2];
#pragma unroll
    for (int a = 0; a < 2; ++a)
#pragma unroll
        for (int b = 0; b < 2; ++b)
#pragma unroll
            for (int m = 0; m < 4; ++m)
#pragma unroll
                for (int n = 0; n < 2; ++n) acc[a][b][m][n] = (f32x4){0.f, 0.f, 0.f, 0.f};
    bf16x8 At[4][2], B0[2][2], B1[2][2];
    const char* cA = (const char*)g.A + (size_t)cur.pm * tstepA + (size_t)cur.k0 * 2; const char* cB = (const char*)g.Bt + (size_t)cur.pn * tstepB + (size_t)cur.k0 * 2;
    PG8_STAGE(PG8_SB(0, 0), cB, voffB); PG8_STAGE(PG8_SA(0, 0), cA, voffA); PG8_STAGE(PG8_SB(0, 1), cB + hstepB, voffB); PG8_STAGE(PG8_SA(0, 1), cA + hstepA, voffA);
    if (wr == 1) PG8_BAR;
    PG8_WAIT_V(4); PG8_BAR;
    PG8_STAGE(PG8_SB(1, 0), cB + kstep, voffB); PG8_STAGE(PG8_SA(1, 0), cA + kstep, voffA); PG8_STAGE(PG8_SB(1, 1), cB + hstepB + kstep, voffB);
    PG8_WAIT_V(6); PG8_BAR;
    for (;;) {
        const bool has_next = S.next(ui + 1, nxt);
        const char* nA = has_next ? (const char*)g.A + (size_t)nxt.pm * tstepA + (size_t)nxt.k0 * 2 : cA; const char* nB = has_next ? (const char*)g.Bt + (size_t)nxt.pn * tstepB + (size_t)nxt.k0 * 2 : cB;
        const int nt = cur.nt;
        for (int t = 0; t < nt; t += 2) {
            const bool last = (t == nt - 2);
            const char* a1 = cA + (size_t)(t + 1) * kstep;
            const char* a2 = last ? nA : cA + (size_t)(t + 2) * kstep; const char* b2 = last ? nB : cB + (size_t)(t + 2) * kstep;
            const char* a3 = a2 + kstep; const char* b3 = b2 + kstep;
            PG8_LDB(B0, 0, 0); PG8_SCHED; PG8_LDA(At, 0, 0); PG8_STAGE(PG8_SA(1, 1), a1 + hstepA, voffA);
            PG8_WAIT_L(8); PG8_BAR; PG8_WAIT_L(0); PG8_MMA(0, 0, At, B0); PG8_BAR; PG8_SCHED;
            PG8_LDB(B1, 0, 1); PG8_STAGE(PG8_SB(0, 0), b2, voffB);
            PG8_BAR; PG8_WAIT_L(0); PG8_MMA(0, 1, At, B1); PG8_BAR;
            PG8_LDA(At, 0, 1); PG8_STAGE(PG8_SA(0, 0), a2, voffA);
            PG8_BAR; PG8_WAIT_L(0); PG8_MMA(1, 0, At, B0); PG8_BAR; PG8_SCHED;
            PG8_STAGE(PG8_SB(0, 1), b2 + hstepB, voffB);
            PG8_WAIT_V(6); PG8_BAR; PG8_MMA(1, 1, At, B1); PG8_BAR;
            PG8_LDB(B0, 1, 0); PG8_SCHED; PG8_LDA(At, 1, 0); PG8_STAGE(PG8_SA(0, 1), a2 + hstepA, voffA);
            PG8_WAIT_L(8); PG8_BAR; PG8_WAIT_L(0); PG8_MMA(0, 0, At, B0); PG8_BAR; PG8_SCHED;
            PG8_LDB(B1, 1, 1); PG8_STAGE(PG8_SB(1, 0), b3, voffB);
            PG8_BAR; PG8_WAIT_L(0); PG8_MMA(0, 1, At, B1); PG8_BAR;
            PG8_LDA(At, 1, 1); PG8_STAGE(PG8_SA(1, 0), a3, voffA);
            PG8_BAR; PG8_WAIT_L(0); PG8_MMA(1, 0, At, B0); PG8_BAR; PG8_SCHED;
            PG8_STAGE(PG8_SB(1, 1), b3 + hstepB, voffB);
            PG8_WAIT_V(6); PG8_BAR; PG8_MMA(1, 1, At, B1); PG8_BAR;
        }
        E(acc, cur, wr, wc, fr, fq);
        if (!has_next) break;
#pragma unroll
        for (int a = 0; a < 2; ++a)
#pragma unroll
            for (int b = 0; b < 2; ++b)
#pragma unroll
                for (int m = 0; m < 4; ++m)
#pragma unroll
                    for (int n = 0; n < 2; ++n) acc[a][b][m][n] = (f32x4){0.f, 0.f, 0.f, 0.f};
        cur = nxt; cA = nA; cB = nB; ++ui;
    }
    PG8_WAIT_V(0);
    if (wr == 0) PG8_BAR;
    PG8_BAR;
#undef PG8_SA
#undef PG8_SB
#undef PG8_STAGE
#undef PG8_LDA
#undef PG8_LDB
#undef PG8_MMA
#undef PG8_WAIT_V
#undef PG8_WAIT_L
#undef PG8_BAR
#undef PG8_SCHED
}
}
using pg8::Unit;

struct EpiSwiGLU {
    static constexpr bool PERM = true;
    bf16_t* hid;
    DI void operator()(const f32x4 (&acc)[2][2][4][2], const Unit& u, int wr, int wc, int fr, int fq) const {
#pragma unroll
        for (int ai = 0; ai < 2; ++ai)
#pragma unroll
            for (int m = 0; m < 4; ++m) {
                const int row = u.pm * 256 + ai * 128 + wr * 64 + m * 16 + fr;
                {
                    float o[8];
#pragma unroll
                    for (int n = 0; n < 2; ++n) { const f32x4 gt = acc[ai][0][m][n], up = acc[ai][1][m][n];
#pragma unroll
                        for (int i = 0; i < 4; ++i) o[4 * n + i] = gt[i] * sigm(gt[i]) * up[i]; }
                    u32x4 w; w.x = pack2(o[0], o[1]); w.y = pack2(o[2], o[3]); w.z = pack2(o[4], o[5]); w.w = pack2(o[6], o[7]);
                    *(u32x4*)(hid + (size_t)row * DFF + u.pn * 128 + wc * 32 + fq * 8) = w;
                }
            }
    }
};
struct EpiResid {
    static constexpr bool PERM = false;
    const float* gate0; float* hc; float* out; const float* hc_src; const float* out_src; float* slab; float coef; int skip_ctx;
    DI void operator()(const f32x4 (&acc)[2][2][4][2], const Unit& u, int wr, int wc, int fr, int fq) const {
        const int b = u.pm / 33, pt = u.pm - b * 33; const int mrow = pt == 0 ? 2 : b;
        if (pt == 0 && skip_ctx) return;
        const float* gate = gate0 + (size_t)mrow * 9216;
        if (u.part) {
            float* base = slab + ((size_t)(u.part - 1) * 512 + (size_t)b * CTX) * DM; const int col0 = u.pn * 256 + wc * 32 + 4 * fq;
#pragma unroll
            for (int ai = 0; ai < 2; ++ai)
#pragma unroll
                for (int m = 0; m < 4; ++m) {
                    float* rowp = base + (size_t)(ai * 128 + wr * 64 + m * 16 + fr) * DM + col0;
#pragma unroll
                    for (int bj = 0; bj < 2; ++bj)
#pragma unroll
                        for (int n = 0; n < 2; ++n) {
                            const f32x4 gv = *(const f32x4*)(gate + col0 + bj * 128 + n * 16);
                            *(f32x4*)(rowp + bj * 128 + n * 16) = coef * gv * acc[ai][bj][m][n];
                        }
                }
            return;
        }
        const size_t boff = pt == 0 ? (size_t)(b * CTX) * DM : (size_t)(b * SEQ + (pt - 1) * 256) * DM;
        float* base = (pt == 0 ? hc : out) + boff; const float* sbase = (pt == 0 ? hc_src : out_src) + boff;
        const int col0 = u.pn * 256 + wc * 32 + 4 * fq;
#pragma unroll
        for (int ai = 0; ai < 2; ++ai)
#pragma unroll
            for (int m = 0; m < 4; ++m) {
                const size_t roff = (size_t)(ai * 128 + wr * 64 + m * 16 + fr) * DM + col0;
                float* rowp = base + roff; const float* srow = sbase + roff;
#pragma unroll
                for (int bj = 0; bj < 2; ++bj)
#pragma unroll
                    for (int n = 0; n < 2; ++n) {
                        const f32x4 gv = *(const f32x4*)(gate + col0 + bj * 128 + n * 16);
                        f32x4 h = *(const f32x4*)(srow + bj * 128 + n * 16);
                        h += coef * gv * acc[ai][bj][m][n];
                        *(f32x4*)(rowp + bj * 128 + n * 16) = h;
                    }
            }
    }
};
struct EpiBf {
    static constexpr bool PERM = true;
    bf16_t* O; int ldo;
    DI void operator()(const f32x4 (&acc)[2][2][4][2], const Unit& u, int wr, int wc, int fr, int fq) const {
        const int col0 = u.pn * 256 + wc * 32 + 8 * fq;
#pragma unroll
        for (int ai = 0; ai < 2; ++ai)
#pragma unroll
            for (int m = 0; m < 4; ++m) {
                bf16_t* rowp = O + (size_t)(u.pm * 256 + ai * 128 + wr * 64 + m * 16 + fr) * ldo + col0;
#pragma unroll
                for (int bj = 0; bj < 2; ++bj) { const f32x4 v0 = acc[ai][bj][m][0], v1 = acc[ai][bj][m][1];
                    u32x4 w; w.x = pack2(v0[0], v0[1]); w.y = pack2(v0[2], v0[3]); w.z = pack2(v1[0], v1[1]); w.w = pack2(v1[2], v1[3]);
                    *(u32x4*)(rowp + bj * 128) = w; }
            }
    }
};

DI void phase_mod(const P& p, float* lf) {
    const int tid = threadIdx.x + oz(), lane = tid & 63, wave = tid >> 6;
    for (int i = tid; i < 3072; i += 512) { const int v = i >> 10, k = i & 1023; const float x = v < 2 ? p.in[1][v * 1024 + k] : p.in[3][k]; lf[i] = x * sigm(x); }
    __syncthreads();
    float* red = lf + 3072;
    for (int unit = blockIdx.x; unit < 288; unit += gridDim.x) {
        const int l = unit / 144, n0 = (unit % 144) * 64;
        const float* W = p.in[4] + (size_t)l * 1024 * 9216 + n0 + lane;
        float a0 = 0.f, a1 = 0.f, a2 = 0.f;
        const int k0 = wave * 128;
#pragma unroll 32
        for (int k = k0; k < k0 + 128; ++k) { const float w = W[(size_t)k * 9216]; a0 += lf[k] * w; a1 += lf[1024 + k] * w; a2 += lf[2048 + k] * w; }
        red[(wave * 3 + 0) * 64 + lane] = a0; red[(wave * 3 + 1) * 64 + lane] = a1; red[(wave * 3 + 2) * 64 + lane] = a2;
        __syncthreads();
        if (tid < 192) { const int v = tid >> 6; float s = 0.f;
#pragma unroll
            for (int w = 0; w < 8; ++w) s += red[(w * 3 + v) * 64 + lane];
            ((float*)(p.ws + WS_MOD))[(size_t)(l * 3 + v) * 9216 + n0 + lane] = s + p.in[5][l * 9216 + n0 + lane]; }
        __syncthreads();
    }
}
DI void phase_hinit(const P& p) {
    const size_t gt = (size_t)blockIdx.x * 512 + threadIdx.x + oz(), gs = (size_t)gridDim.x * 512;
    const f32x4* x4 = (const f32x4*)p.in[0]; f32x4* o4 = (f32x4*)p.out;
    for (size_t i = gt; i < (size_t)NB * SEQ * DM / 4; i += gs) o4[i] = x4[i];
    const f32x4* c4 = (const f32x4*)p.in[2]; f32x4* h4 = (f32x4*)(p.ws + WS_HC);
    for (size_t i = gt; i < (size_t)NB * CTX * DM / 4; i += gs) h4[i] = c4[i];
}
template <class F> DI void conv_tiles(bf16_t* dst, int Np, int K, F f, float* tile, int& tcount) {
    const int tid = threadIdx.x + oz(), nkt = K / 64, ntile = (Np / 64) * nkt;
    const int G_ = (int)gridDim.x, first_ = (((int)blockIdx.x - tcount) % G_ + G_) % G_;
    tcount += ntile;
    for (int ti = first_; ti < ntile; ti += G_) {
        const int n0 = (ti / nkt) * 64, k0 = (ti % nkt) * 64;
        const int ty = tid >> 6, tx = tid & 63;
#pragma unroll
        for (int i = 0; i < 8; ++i) tile[(ty * 8 + i) * 65 + tx] = f(k0 + ty * 8 + i, n0 + tx);
        __syncthreads();
        const int r = tid >> 3, c8 = (tid & 7) * 8;
        u32x4 w; w.x = pack2(tile[(c8 + 0) * 65 + r], tile[(c8 + 1) * 65 + r]); w.y = pack2(tile[(c8 + 2) * 65 + r], tile[(c8 + 3) * 65 + r]);
        w.z = pack2(tile[(c8 + 4) * 65 + r], tile[(c8 + 5) * 65 + r]); w.w = pack2(tile[(c8 + 6) * 65 + r], tile[(c8 + 7) * 65 + r]);
        *(u32x4*)(dst + (size_t)(n0 + r) * K + k0 + c8) = w;
        __syncthreads();
    }
}
template <class F> DI void conv_tiles4(bf16_t* dst, int Np, int K, F f, float* tile, int& tcount) {
    const int tid = threadIdx.x + oz(), nkt = K / 256, ntile = (Np / 64) * nkt;
    for (int ti = 0; ti < ntile; ++ti, ++tcount) {
        if ((tcount % (int)gridDim.x) != (int)blockIdx.x) continue;
        const int n0 = (ti / nkt) * 64, k0 = (ti % nkt) * 256;
        const int ty = tid >> 6, tx = tid & 63;
        float v[32];
#pragma unroll
        for (int i = 0; i < 32; ++i) v[i] = f(k0 + ty * 32 + i, n0 + tx);
#pragma unroll
        for (int i = 0; i < 32; ++i) tile[(ty * 32 + i) * 65 + tx] = v[i];
        __syncthreads();
        const int r = tid >> 3;
#pragma unroll
        for (int q = 0; q < 4; ++q) {
            const int c8 = (tid & 7) * 8 + 64 * q;
            u32x4 w; w.x = pack2(tile[(c8 + 0) * 65 + r], tile[(c8 + 1) * 65 + r]); w.y = pack2(tile[(c8 + 2) * 65 + r], tile[(c8 + 3) * 65 + r]);
            w.z = pack2(tile[(c8 + 4) * 65 + r], tile[(c8 + 5) * 65 + r]); w.w = pack2(tile[(c8 + 6) * 65 + r], tile[(c8 + 7) * 65 + r]);
            *(u32x4*)(dst + (size_t)(n0 + r) * K + k0 + c8) = w;
        }
        __syncthreads();
    }
}
template <class F4> DI void conv_tilesN(bf16_t* dst, int Np, int K, F4 f4, float* tile, int& tcount) {
    const int tid = threadIdx.x + oz(), nkt = K / 64, ntile = (Np / 256) * nkt;
    const int G_ = (int)gridDim.x, first_ = (((int)blockIdx.x - tcount) % G_ + G_) % G_;
    tcount += ntile;
    for (int ti = first_; ti < ntile; ti += G_) {
        const int n0 = (ti / nkt) * 256, k0 = (ti % nkt) * 64;
        const int ty = tid >> 6, tx = tid & 63;
        f32x4 v[8];
#pragma unroll
        for (int i = 0; i < 8; ++i) v[i] = f4(k0 + ty * 8 + i, n0 + tx * 4);
#pragma unroll
        for (int i = 0; i < 8; ++i) { float* t_ = tile + (ty * 8 + i) * 257 + tx * 4; t_[0] = v[i][0]; t_[1] = v[i][1]; t_[2] = v[i][2]; t_[3] = v[i][3]; }
        __syncthreads();
        const int r = tid >> 1, kh = (tid & 1) * 32;
#pragma unroll
        for (int q = 0; q < 4; ++q) {
            const int kb = kh + q * 8;
            u32x4 w; w.x = pack2(tile[(kb + 0) * 257 + r], tile[(kb + 1) * 257 + r]); w.y = pack2(tile[(kb + 2) * 257 + r], tile[(kb + 3) * 257 + r]);
            w.z = pack2(tile[(kb + 4) * 257 + r], tile[(kb + 5) * 257 + r]); w.w = pack2(tile[(kb + 6) * 257 + r], tile[(kb + 7) * 257 + r]);
            *(u32x4*)(dst + (size_t)(n0 + r) * K + k0 + kb) = w;
        }
        __syncthreads();
    }
}
DI void phase_weights(const P& p, int l, int part, float* tile) {
    int tc = 0;
    const f32x4 z4 = {0.f, 0.f, 0.f, 0.f};
    {
        const float* Wgu = p.in[part ? 35 : 7] + (size_t)l * DM * 2 * DFF;
        conv_tilesN((bf16_t*)(p.ws + WS_WGU), 5632, 1024,
                    [=](int k, int n) { const int pp = n >> 8, hf = (n >> 7) & 1, j = n & 127; return *(const f32x4*)(Wgu + (size_t)k * 5632 + hf * DFF + pp * 128 + j); }, tile, tc);
        const float* Wd = p.in[part ? 36 : 8] + (size_t)l * DFF * DM;
        conv_tilesN((bf16_t*)(p.ws + WS_WD), 1024, DFF, [=](int k, int n) { return *(const f32x4*)(Wd + (size_t)k * 1024 + n); }, tile, tc);
    }
    if (part) return;
    const float* Win = p.in[10] + (size_t)l * DM * NIN;
    conv_tilesN((bf16_t*)(p.ws + WS_WIN), NINP, 1024, [=](int k, int n) { return n < NIN ? *(const f32x4*)(Win + (size_t)k * NIN + n) : z4; }, tile, tc);
    const float* Wo = p.in[11] + (size_t)l * DM * DM;
    conv_tilesN((bf16_t*)(p.ws + WS_WOUT), 1024, 1024, [=](int k, int n) { return *(const f32x4*)(Wo + (size_t)k * 1024 + n); }, tile, tc);
    const float* qn = p.in[12] + l * 256; const float* kvn = p.in[13] + l * 128; const float* wuq = p.in[14] + (size_t)l * 256 * 384; const float* wukv = p.in[15] + (size_t)l * 128 * 512;
    conv_tiles((bf16_t*)(p.ws + WS_WMLA), 1024, 384, [=](int k, int n) {
        float v = 0.f;
        if (n < 384) { if (k < 256) v = qn[k] * wuq[k * 384 + n]; }
        else if (n < 896) { if (k >= 256) v = kvn[k - 256] * wukv[(k - 256) * 512 + (n - 384)]; }
        return v; }, tile, tc);
}

DI void phase_norm(const P& p, int l, int which, int first = 0, int fold = 0) {
    const int tid_ = threadIdx.x + oz(), lane = tid_ & 63, wave = tid_ >> 6;
    const float* gain = p.in[which == 0 ? 6 : (which == 1 ? 9 : 34)] + l * DM;
    bf16_t* A = (bf16_t*)(p.ws + WS_A);
    f32x4 gv[4];
#pragma unroll
    for (int i = 0; i < 4; ++i) gv[i] = *(const f32x4*)(gain + (lane + 64 * i) * 4);
    for (int g0 = (blockIdx.x * 8 + wave) * 2; g0 < MT; g0 += gridDim.x * 16) {
        f32x4 x[2][4];
#pragma unroll
        for (int rr = 0; rr < 2; ++rr) { const int gg_ = g0 + rr, bb_ = gg_ / TT, tt_ = gg_ - bb_ * TT;
            const float* h = first ? (tt_ < CTX ? p.in[2] + (size_t)(bb_ * CTX + tt_) * DM : p.in[0] + (size_t)(bb_ * SEQ + tt_ - CTX) * DM) : (const float*)hrow(p, gg_);
#pragma unroll
            for (int i = 0; i < 4; ++i) x[rr][i] = *(const f32x4*)(h + (lane + 64 * i) * 4);
            if (fold && tt_ < CTX) {
                const float* sl = (const float*)(p.ws + WS_SLAB) + (size_t)(bb_ * CTX + tt_) * DM; float* hw = (float*)(p.ws + WS_HC) + (size_t)(bb_ * CTX + tt_) * DM;
#pragma unroll
                for (int i = 0; i < 4; ++i) {
#pragma unroll
                    for (int sidx = 0; sidx < 8; ++sidx) if (sidx < fold) x[rr][i] += *(const f32x4*)(sl + (size_t)sidx * 512 * DM + (lane + 64 * i) * 4);
                    *(f32x4*)(hw + (lane + 64 * i) * 4) = x[rr][i];
                }
            } }
#pragma unroll
        for (int rr = 0; rr < 2; ++rr) {
            const int g = g0 + rr, b = g / TT, t = g - b * TT, mrow = t < CTX ? 2 : b;
            const float* sh = modp(p, l, mrow, which * 3); const float* sc = modp(p, l, mrow, which * 3 + 1);
            float ss = 0.f;
#pragma unroll
            for (int i = 0; i < 4; ++i) ss += x[rr][i][0] * x[rr][i][0] + x[rr][i][1] * x[rr][i][1] + x[rr][i][2] * x[rr][i][2] + x[rr][i][3] * x[rr][i][3];
            ss = red64(ss);
            const float rinv = rsqrtf(ss * (1.0f / DM) + 1e-6f);
#pragma unroll
            for (int i = 0; i < 4; ++i) {
                const f32x4 s4 = *(const f32x4*)(sc + (lane + 64 * i) * 4), h4 = *(const f32x4*)(sh + (lane + 64 * i) * 4);
                const f32x4 y = (x[rr][i] * rinv * gv[i]) * (1.0f + s4) + h4;
                *(u32x2*)(A + (size_t)g * DM + (lane + 64 * i) * 4) = pack4(y[0], y[1], y[2], y[3]);
            }
        }
    }
}

constexpr int VLS = 40, PT = 32;
DI void vt_flush(const bf16_t* lv, bf16_t* Vt, int nch, int b, int t0) {
    const int tid = threadIdx.x + oz();
    for (int idx = tid; idx < nch * 4; idx += 512) {
        const int c = idx >> 2, q = idx & 3;
        *(u32x4*)(Vt + ((size_t)b * nch + c) * TT + t0 + q * 8) = *(const u32x4*)(lv + c * VLS + q * 8);
    }
}
DI void lv_put(bf16_t* lv, int ch0, int tl, u32x2 v) {
    lv[(ch0 + 0) * VLS + tl] = (bf16_t)(v.x & 0xffff); lv[(ch0 + 1) * VLS + tl] = (bf16_t)(v.x >> 16);
    lv[(ch0 + 2) * VLS + tl] = (bf16_t)(v.y & 0xffff); lv[(ch0 + 3) * VLS + tl] = (bf16_t)(v.y >> 16);
}
DI void rope_tab(int i, int half, float pos, float& cs, float& sn) {
    const float inv = exp2f(-13.287712379549449f * (float)i / (float)half);
    const float ang = pos * inv, rev = ang * 0.15915494309189535f;
    cs = __builtin_amdgcn_cosf(rev); sn = __builtin_amdgcn_sinf(rev);
}
DI f32x4 rw_shift(const bf16_t* u, int c, bool hp, bool hn, const float* mu) {
    const f32x4 z4 = {0.f, 0.f, 0.f, 0.f};
    const f32x4 x = ldbf4(u + c), xp = hp ? ldbf4(u - NINP + c) : z4, xn = hn ? ldbf4(u + NINP + c) : z4;
    const f32x4 m0 = *(const f32x4*)(mu + c), m1 = *(const f32x4*)(mu + 960 + c);
    return x + m0 * (xp - x) + m1 * (xn - x);
}
DI void phase_prep1(const P& p, int l, unsigned char* ldsb) {
    const int tid = threadIdx.x + oz(), lane = tid & 63, wave = tid >> 6, l15 = lane & 15;
    const bf16_t* U = (const bf16_t*)(p.ws + WS_U);
    bf16_t* lvC = (bf16_t*)ldsb;
    bf16_t* lvD = lvC + 256 * VLS;
    bf16_t* wl = (bf16_t*)ldsb;
    float* lora = (float*)(ldsb + 192 * 256 * 2);
    float* mylora = lora + wave * 768;
    const float* mu = p.in[18] + (size_t)l * 2 * 960;
    const float* w0 = p.in[19] + l * 512; const float* w2 = p.in[20] + (size_t)l * 2 * 32 * 256; const float* a0 = p.in[21] + l * 512; const float* a2 = p.in[22] + (size_t)l * 2 * 32 * 256;
    const float* g2 = p.in[23] + (size_t)l * 64 * 256; const float* k_k = p.in[24] + l * 256; const float* k_a = p.in[25] + l * 256; const float* r_k = p.in[26] + l * 256;
    bf16_t* QC = (bf16_t*)(p.ws + WS_QC); bf16_t* KC = (bf16_t*)(p.ws + WS_KC); bf16_t* QD = (bf16_t*)(p.ws + WS_QD); bf16_t* KD = (bf16_t*)(p.ws + WS_KD);
    bf16_t* FS = (bf16_t*)(p.ws + WS_FS); bf16_t* FD = (bf16_t*)(p.ws + WS_FD); bf16_t* G = (bf16_t*)(p.ws + WS_G); float* BON = (float*)(p.ws + WS_BON);
    const f32x4 nqn = *(const f32x4*)(p.in[29] + l * 64 + l15 * 4), nkn = *(const f32x4*)(p.in[30] + l * 64 + l15 * 4), gqn = *(const f32x4*)(p.in[32] + l * 64 + l15 * 4), gkn = *(const f32x4*)(p.in[33] + l * 64 + l15 * 4);
    constexpr int TPB = TT / PT;
    const int nx3_ = (NB * TPB) % (int)gridDim.x, nA_ = (int)gridDim.x > nx3_ ? (int)gridDim.x - nx3_ : (int)gridDim.x;
    for (int tile = nA_ - 1 - (int)blockIdx.x; tile >= 0 && tile < NB * TPB; tile += nA_) {
        const int b = tile / TPB, t0 = (tile - b * TPB) * PT, tw = t0 + wave * 4;
        {
            u32x2 nq[4], nk[4], nv[4], gq[4], gk[4], gv[4];
#pragma unroll
            for (int q = 0; q < 4; ++q) {
                const bf16_t* u = U + (size_t)(b * TT + tw + q) * NINP;
                nq[q] = *(const u32x2*)(u + C_NA + lane * 4); nk[q] = *(const u32x2*)(u + C_NA + 256 + lane * 4); nv[q] = *(const u32x2*)(u + C_NA + 512 + lane * 4);
                gq[q] = *(const u32x2*)(u + C_GQ + lane * 4); gk[q] = *(const u32x2*)(u + C_GQ + 256 + (lane & 31) * 4); gv[q] = *(const u32x2*)(u + C_GQ + 384 + (lane & 31) * 4);
            }
#pragma unroll
            for (int qi = 0; qi < 4; ++qi) {
                const int tl = wave * 4 + qi, t = t0 + tl, g = b * TT + t;
                {
                    f32x4 q = unpack4(nq[qi]), k = unpack4(nk[qi]);
                    const float sq = red16(q[0] * q[0] + q[1] * q[1] + q[2] * q[2] + q[3] * q[3]), sk = red16(k[0] * k[0] + k[1] * k[1] + k[2] * k[2] + k[3] * k[3]);
                    const float rq = rsqrtf(sq * (1.f / 64) + 1e-6f), rk = rsqrtf(sk * (1.f / 64) + 1e-6f);
                    q = q * rq * nqn; k = k * rk * nkn;
                    *(u32x2*)(QC + (size_t)g * 256 + lane * 4) = pack4(q[0], q[1], q[2], q[3]);
                    *(u32x2*)(KC + (size_t)g * 256 + lane * 4) = pack4(k[0], k[1], k[2], k[3]);
                    lv_put(lvC, lane * 4, tl, nv[qi]);
                }
                {
                    const bool lat = t >= CTX; const int s = t - CTX; const float pos = (float)((lane & 8) ? (s & 63) : (s >> 6));
                    f32x4 q = unpack4(gq[qi]), k = unpack4(gk[qi]);
                    const float sq = red16(q[0] * q[0] + q[1] * q[1] + q[2] * q[2] + q[3] * q[3]), sk = red16(k[0] * k[0] + k[1] * k[1] + k[2] * k[2] + k[3] * k[3]);
                    const float rq = rsqrtf(sq * (1.f / 64) + 1e-6f), rk = rsqrtf(sk * (1.f / 64) + 1e-6f);
                    q = q * rq * gqn; k = k * rk * gkn;
                    f32x4 qo = q, ko = k;
                    const bool isx1 = (lane & 4) == 0;
#pragma unroll
                    for (int j = 0; j < 4; ++j) {
                        const float qp = __shfl_xor(q[j], 4), kp = __shfl_xor(k[j], 4);
                        float cs, sn; rope_tab((lane & 3) * 4 + j, 16, pos, cs, sn);
                        if (lat) { qo[j] = isx1 ? q[j] * cs - qp * sn : qp * sn + q[j] * cs; ko[j] = isx1 ? k[j] * cs - kp * sn : kp * sn + k[j] * cs; }
                    }
                    *(u32x2*)(QD + (size_t)g * 256 + lane * 4) = pack4(qo[0], qo[1], qo[2], qo[3]);
                    if (lane < 32) { *(u32x2*)(KD + (size_t)g * 128 + lane * 4) = pack4(ko[0], ko[1], ko[2], ko[3]); lv_put(lvD, lane * 4, tl, gv[qi]); }
                }
            }
        }
        __syncthreads();
        vt_flush(lvC, (bf16_t*)(p.ws + WS_VTC), 256, b, t0);
        vt_flush(lvD, (bf16_t*)(p.ws + WS_VTD), 128, b, t0);
        __syncthreads();
    }
    {
        for (int i = tid; i < 192 * 64; i += 512) {
            const int j = i >> 6, c4 = (i & 63) * 4;
            const float* src = j < 64 ? w2 + (size_t)j * 256 : (j < 128 ? a2 + (size_t)(j - 64) * 256 : g2 + (size_t)(j - 128) * 256);
            const f32x4 v = *(const f32x4*)(src + c4);
            *(u32x2*)(wl + j * 256 + c4) = pack4(v[0], v[1], v[2], v[3]);
        }
    }
    for (int tile = (int)gridDim.x - 1 - (int)blockIdx.x; tile < NB * TPB; tile += gridDim.x) {
        const int b = tile / TPB, t0 = (tile - b * TPB) * PT, tw = t0 + wave * 4;
        {
#pragma unroll
            for (int q = 0; q < 4; ++q) {
                const int t = tw + q;
                const bool hp = (t != 0) && (t != CTX), hn = (t != CTX - 1) && (t != TT - 1);
                if (lane < 48) {
                    const f32x4 y = rw_shift(U + (size_t)(b * TT + t) * NINP + C_RW, 768 + lane * 4, hp, hn, mu);
#pragma unroll
                    for (int j = 0; j < 4; ++j) { float v = y[j]; if (lane < 16) { const float ex = __expf(2.0f * v); v = 1.0f - 2.0f / (ex + 1.0f); } else if (lane >= 32) v = sigm(v); mylora[(lane * 4 + j) * 4 + q] = v; }
                }
            }
            __syncthreads();
            f32x4 zw[2][4], za[2][4], gg[4];
#pragma unroll
            for (int d = 0; d < 2; ++d) { const f32x4 w0v = *(const f32x4*)(w0 + d * 256 + lane * 4), a0v = *(const f32x4*)(a0 + d * 256 + lane * 4);
#pragma unroll
                for (int q = 0; q < 4; ++q) { zw[d][q] = w0v; za[d][q] = a0v; } }
#pragma unroll
            for (int q = 0; q < 4; ++q) gg[q] = (f32x4){0.f, 0.f, 0.f, 0.f};
#pragma unroll 4
            for (int j = 0; j < 32; ++j) {
#pragma unroll
                for (int d = 0; d < 2; ++d) {
                    const f32x4 ww = ldbf4(wl + (d * 32 + j) * 256 + lane * 4), aw = ldbf4(wl + (64 + d * 32 + j) * 256 + lane * 4);
                    const f32x4 tw4 = *(const f32x4*)(mylora + (d * 32 + j) * 4), ta = *(const f32x4*)(mylora + (64 + d * 32 + j) * 4);
#pragma unroll
                    for (int q = 0; q < 4; ++q) { zw[d][q] += tw4[q] * ww; za[d][q] += ta[q] * aw; }
                }
            }
#pragma unroll 4
            for (int j = 0; j < 64; ++j) {
                const f32x4 gw = ldbf4(wl + (128 + j) * 256 + lane * 4); const f32x4 tg = *(const f32x4*)(mylora + (128 + j) * 4);
#pragma unroll
                for (int q = 0; q < 4; ++q) gg[q] += tg[q] * gw;
            }
            const f32x4 kkv = *(const f32x4*)(k_k + lane * 4), kav = *(const f32x4*)(k_a + lane * 4), rkv = *(const f32x4*)(r_k + lane * 4);
            f32x4 nxr, nxk, nxv;
            { const int t = tw; const bool hp = (t != 0) && (t != CTX), hn = (t != CTX - 1) && (t != TT - 1); const bf16_t* u = U + (size_t)(b * TT + t) * NINP + C_RW;
              nxr = rw_shift(u, lane * 4, hp, hn, mu); nxk = rw_shift(u, 256 + lane * 4, hp, hn, mu); nxv = rw_shift(u, 512 + lane * 4, hp, hn, mu); }
#pragma unroll
            for (int q = 0; q < 4; ++q) {
                const int t = tw + q, g = b * TT + t;
                const f32x4 xrq = nxr, xkq = nxk, xvq = nxv;
                asm volatile("" ::: "memory");
                if (q < 3) { const int t1 = t + 1; const bool hp = (t1 != 0) && (t1 != CTX), hn = (t1 != CTX - 1) && (t1 != TT - 1); const bf16_t* u = U + (size_t)(b * TT + t1) * NINP + C_RW;
                    nxr = rw_shift(u, lane * 4, hp, hn, mu); nxk = rw_shift(u, 256 + lane * 4, hp, hn, mu); nxv = rw_shift(u, 512 + lane * 4, hp, hn, mu); }
                f32x4 kk = xkq * kkv;
                const float ss = red16(kk[0] * kk[0] + kk[1] * kk[1] + kk[2] * kk[2] + kk[3] * kk[3]);
                kk = kk * rsqrtf(ss + 1e-12f);
                const size_t fb = (size_t)g * 1024 + (lane >> 4) * 256 + l15 * 4;
                *(u32x2*)(FS + fb) = pack4(xrq[0], xrq[1], xrq[2], xrq[3]);
                *(u32x2*)(FS + fb + 64) = pack4(xkq[0], xkq[1], xkq[2], xkq[3]);
                *(u32x2*)(FS + fb + 128) = pack4(kk[0], kk[1], kk[2], kk[3]);
                *(u32x2*)(FS + fb + 192) = pack4(xvq[0], xvq[1], xvq[2], xvq[3]);
                float bon = 0.f;
#pragma unroll
                for (int d = 0; d < 2; ++d) {
                    f32x4 e, a;
#pragma unroll
                    for (int j = 0; j < 4; ++j) { e[j] = 0.6065306597126334f * sigm(zw[d][q][j]); a[j] = sigm(za[d][q][j]);
                        const float kd = xkq[j] * (1.0f + (a[j] - 1.0f) * kav[j]); bon += xrq[j] * kd * rkv[j]; }
                    *(u32x2*)(FD + fb + d * 128) = pack4(e[0], e[1], e[2], e[3]);
                    *(u32x2*)(FD + fb + d * 128 + 64) = pack4(a[0], a[1], a[2], a[3]);
                }
                bon = red16(bon);
                if (l15 == 0) BON[(size_t)g * 4 + (lane >> 4)] = bon;
                *(u32x2*)(G + (size_t)g * 256 + lane * 4) = pack4(gg[q][0], gg[q][1], gg[q][2], gg[q][3]);
            }
        }
        __syncthreads();
    }
}
DI void phase_prep2(const P& p, int l, unsigned char* ldsb) {
    const int tid = threadIdx.x + oz(), lane = tid & 63, wave = tid >> 6, l15 = lane & 15, hd = lane >> 4;
    const bf16_t* U = (const bf16_t*)(p.ws + WS_U); const bf16_t* RAW = (const bf16_t*)(p.ws + WS_A);
    bf16_t* QA = (bf16_t*)(p.ws + WS_QA); bf16_t* KA = (bf16_t*)(p.ws + WS_KA);
    bf16_t* lv = (bf16_t*)ldsb;
    const float* qn = p.in[16] + l * 96; const float* kn = p.in[17] + l * 96;
    const f32x4 qn4 = *(const f32x4*)(qn + l15 * 4), kn4 = *(const f32x4*)(kn + l15 * 4);
    const f32x2 qn2 = *(const f32x2*)(qn + 64 + l15 * 2), kn2 = *(const f32x2*)(kn + 64 + l15 * 2);
    constexpr int TPB = TT / PT;
    for (int tile = blockIdx.x; tile < NB * TPB; tile += gridDim.x) {
        const int b = tile / TPB, t0 = (tile - b * TPB) * PT, tw = t0 + wave * 4;
        u32x2 i_uq[4], i_qa[4], i_ka[4], i_va[4]; unsigned i_ukv[4], i_qb[4], i_kb[4];
#pragma unroll
        for (int q = 0; q < 4; ++q) {
            const int t = tw + q; const bf16_t* u = U + (size_t)(b * TT + t) * NINP; const bf16_t* raw = RAW + (size_t)(b * TT + t) * 1024;
            i_uq[q] = *(const u32x2*)(u + lane * 4); i_ukv[q] = *(const unsigned*)(u + 256 + lane * 2); i_kb[q] = *(const unsigned*)(u + 384 + l15 * 2);
            i_qa[q] = *(const u32x2*)(raw + hd * 96 + l15 * 4); i_qb[q] = *(const unsigned*)(raw + hd * 96 + 64 + l15 * 2);
            i_ka[q] = *(const u32x2*)(raw + 384 + hd * 128 + l15 * 4); i_va[q] = *(const u32x2*)(raw + 384 + hd * 128 + 64 + l15 * 4);
        }
#pragma unroll
        for (int qi = 0; qi < 4; ++qi) {
            const int tl = wave * 4 + qi, t = t0 + tl, g = b * TT + t;
            const f32x4 uq = unpack4(i_uq[qi]);
            const float sq = red64(uq[0] * uq[0] + uq[1] * uq[1] + uq[2] * uq[2] + uq[3] * uq[3]);
            const f32x2 ukv = {__uint_as_float(i_ukv[qi] << 16), __uint_as_float(i_ukv[qi] & 0xffff0000u)};
            const float skv = red64(ukv[0] * ukv[0] + ukv[1] * ukv[1]);
            const float rq = rsqrtf(sq * (1.f / 256) + 1e-6f), rkv = rsqrtf(skv * (1.f / 128) + 1e-6f);
            f32x4 qa = unpack4(i_qa[qi]) * rq;
            f32x2 qb = {__uint_as_float(i_qb[qi] << 16) * rq, __uint_as_float(i_qb[qi] & 0xffff0000u) * rq};
            f32x4 ka = unpack4(i_ka[qi]) * rkv;
            f32x2 kb = {__uint_as_float(i_kb[qi] << 16), __uint_as_float(i_kb[qi] & 0xffff0000u)};
            const f32x4 va = unpack4(i_va[qi]) * rkv;
            const float ssq = red16(qa[0] * qa[0] + qa[1] * qa[1] + qa[2] * qa[2] + qa[3] * qa[3] + qb[0] * qb[0] + qb[1] * qb[1]);
            const float ssk = red16(ka[0] * ka[0] + ka[1] * ka[1] + ka[2] * ka[2] + ka[3] * ka[3] + kb[0] * kb[0] + kb[1] * kb[1]);
            const float r1 = rsqrtf(ssq * (1.f / 96) + 1e-6f), r2 = rsqrtf(ssk * (1.f / 96) + 1e-6f);
            qa = qa * r1 * qn4; qb = qb * r1 * qn2; ka = ka * r2 * kn4; kb = kb * r2 * kn2;
            const bool lat = t >= CTX; const int s = t - CTX; const float pos = (float)((lane & 8) ? (s & 63) : (s >> 6));
            f32x2 qo = qb, ko = kb; const bool isx1 = (lane & 4) == 0;
#pragma unroll
            for (int j = 0; j < 2; ++j) {
                const float qp = __shfl_xor(qb[j], 4), kp = __shfl_xor(kb[j], 4);
                float cs, sn; rope_tab((lane & 3) * 2 + j, 8, pos, cs, sn);
                if (lat) { qo[j] = isx1 ? qb[j] * cs - qp * sn : qp * sn + qb[j] * cs; ko[j] = isx1 ? kb[j] * cs - kp * sn : kp * sn + kb[j] * cs; }
            }
            *(u32x2*)(QA + (size_t)g * 384 + hd * 96 + l15 * 4) = pack4(qa[0], qa[1], qa[2], qa[3]);
            *(unsigned*)(QA + (size_t)g * 384 + hd * 96 + 64 + l15 * 2) = pack2(qo[0], qo[1]);
            *(u32x2*)(KA + (size_t)g * 384 + hd * 96 + l15 * 4) = pack4(ka[0], ka[1], ka[2], ka[3]);
            *(unsigned*)(KA + (size_t)g * 384 + hd * 96 + 64 + l15 * 2) = pack2(ko[0], ko[1]);
            lv_put(lv, lane * 4, tl, pack4(va[0], va[1], va[2], va[3]));
        }
        __syncthreads();
        vt_flush(lv, (bf16_t*)(p.ws + WS_VTA), 256, b, t0);
        __syncthreads();
    }
}

#define MFMA32(a, b, c) __builtin_amdgcn_mfma_f32_32x32x16_bf16((a), (b), (c), 0, 0, 0)
DI bf16x8 pack8(const f32x16& x, int s) {
    u32x4 w; w.x = pack2(x[8 * s + 0], x[8 * s + 1]); w.y = pack2(x[8 * s + 2], x[8 * s + 3]); w.z = pack2(x[8 * s + 4], x[8 * s + 5]); w.w = pack2(x[8 * s + 6], x[8 * s + 7]);
    return __builtin_bit_cast(bf16x8, w);
}
DI bf16x8 ldv8(const bf16_t* p) { const s16x4 lo = *(const s16x4*)p, hi = *(const s16x4*)(p + 8); return __builtin_shufflevector(lo, hi, 0, 1, 2, 3, 4, 5, 6, 7); }
struct AttState { f32x16 o0, o1; float m, l; };
DI void attn_update(AttState& st, f32x16& t, const bf16_t* vt  ) {
    float mx = t[0];
#pragma unroll
    for (int i = 1; i < 16; ++i) mx = fmaxf(mx, t[i]);
    mx = fmaxf(mx, __shfl_xor(mx, 32));
    const float mn = fmaxf(st.m, mx), alpha = __builtin_amdgcn_exp2f(st.m - mn);
    float ps = 0.f;
#pragma unroll
    for (int i = 0; i < 16; ++i) { t[i] = __builtin_amdgcn_exp2f(t[i] - mn); ps += t[i]; }
    st.l = st.l * alpha + ps; st.m = mn;
    st.o0 *= alpha; st.o1 *= alpha;
    const bf16x8 p0 = pack8(t, 0), p1 = pack8(t, 1);
    st.o0 = MFMA32(ldv8(vt), p0, st.o0); st.o0 = MFMA32(ldv8(vt + 16), p1, st.o0);
    st.o1 = MFMA32(ldv8(vt + (size_t)32 * TT), p0, st.o1); st.o1 = MFMA32(ldv8(vt + (size_t)32 * TT + 16), p1, st.o1);
}
DI void attn_store(AttState& st, bf16_t* orow  , int hh) {
    const float l = st.l + __shfl_xor(st.l, 32), inv = 1.0f / l;
#pragma unroll
    for (int g4 = 0; g4 < 4; ++g4) {
        *(u32x2*)(orow + 8 * g4 + 4 * hh) = pack4(st.o0[4 * g4] * inv, st.o0[4 * g4 + 1] * inv, st.o0[4 * g4 + 2] * inv, st.o0[4 * g4 + 3] * inv);
        *(u32x2*)(orow + 32 + 8 * g4 + 4 * hh) = pack4(st.o1[4 * g4] * inv, st.o1[4 * g4 + 1] * inv, st.o1[4 * g4 + 2] * inv, st.o1[4 * g4 + 3] * inv);
    }
}
template <int DQ>
DI void attn_dense_wave(const bf16_t* Qp, int qstride, const bf16_t* Kp, int kstride, const bf16_t* Vt, int nkeys, float sc_log2, bf16_t* Op, int lane) {
    const int r = lane & 31, hh = lane >> 5;
    bf16x8 qf[DQ / 16];
#pragma unroll
    for (int s = 0; s < DQ / 16; ++s) qf[s] = *(const bf16x8*)(Qp + (size_t)r * qstride + s * 16 + hh * 8);
    AttState st;
#pragma unroll
    for (int i = 0; i < 16; ++i) { st.o0[i] = 0.f; st.o1[i] = 0.f; }
    st.m = -1e30f; st.l = 0.f;
    const bf16_t* kp = Kp + (size_t)r * kstride + hh * 8;
    const bf16_t* vp = Vt + (size_t)r * TT + 4 * hh;
#pragma unroll 1
    for (int kt = 0; kt < nkeys; kt += 32) {
        f32x16 s;
#pragma unroll
        for (int i = 0; i < 16; ++i) s[i] = 0.f;
#pragma unroll
        for (int st2 = 0; st2 < DQ / 16; ++st2) s = MFMA32(*(const bf16x8*)(kp + (size_t)kt * kstride + st2 * 16), qf[st2], s);
#pragma unroll
        for (int i = 0; i < 16; ++i) s[i] *= sc_log2;
        attn_update(st, s, vp + kt);
    }
    attn_store(st, Op + (size_t)r * 1024, hh);
}

template <int DQ>
DI void attn_block(const bf16_t* Qw, int qstride, const bf16_t* Kg, int kstride, const bf16_t* Vtg, int nkeys, float sc_log2, bf16_t* Ow, LAS unsigned char* lds, int tid) {
    constexpr int KST = DQ * 2 + 16, VST = 144, KBYTES = 64 * KST, VBYTES = 64 * VST, STAGE = KBYTES + VBYTES;
    constexpr int KPC = 64 * DQ / 8, VPC = 512, NI = (KPC + VPC + 511) / 512, CPR = DQ / 8;
    const int lane = tid & 63, r = lane & 31, hh = lane >> 5;
    bf16x8 qf[DQ / 16];
#pragma unroll
    for (int s = 0; s < DQ / 16; ++s) qf[s] = *(const bf16x8*)(Qw + (size_t)r * qstride + s * 16 + hh * 8);
#pragma unroll
    for (int s = 0; s < DQ / 16; ++s) asm volatile("" :: "v"(qf[s]));
    f32x16 o0, o1;
#pragma unroll
    for (int i = 0; i < 16; ++i) { o0[i] = 0.f; o1[i] = 0.f; }
    float m = -1e30f, l = 0.f;
    u32x4 sA[NI], sB[NI];
    const bf16_t* gsrc[NI]; int ldst[NI]; int kind[NI]; int gstep[NI];
#pragma unroll
    for (int i = 0; i < NI; ++i) {
        const int pid = tid + 512 * i;
        if (pid < KPC) { const int key = pid / CPR, c8 = pid % CPR; gsrc[i] = Kg + (size_t)key * kstride + c8 * 8; ldst[i] = key * KST + c8 * 16; kind[i] = 0; gstep[i] = 64 * kstride; }
        else if (pid < KPC + VPC) { const int pv = pid - KPC, dv = pv >> 3, c8 = pv & 7; gsrc[i] = Vtg + (size_t)dv * TT + c8 * 8; ldst[i] = KBYTES + dv * VST + (c8 >> 1) * 32 + (c8 & 1) * 8; kind[i] = 1; gstep[i] = 64; }
        else { gsrc[i] = Kg; ldst[i] = 0; kind[i] = 2; gstep[i] = 0; }
    }
    const int nt = nkeys / 64;
#define AT_GLOAD(SET, jt) do { if ((jt) < nt) { _Pragma("unroll") for (int i = 0; i < NI; ++i) if (kind[i] != 2) SET[i] = *(const u32x4*)(gsrc[i] + (size_t)(jt) * gstep[i]); } } while (0)
#define AT_LSTORE(SET, jt) do { if ((jt) < nt) { LAS unsigned char* nb_ = lds + ((jt) & 1) * STAGE; _Pragma("unroll") for (int i = 0; i < NI; ++i) { \
        if (kind[i] == 0) *(LAS u32x4*)(nb_ + ldst[i]) = SET[i]; \
        else if (kind[i] == 1) { *(LAS u32x2*)(nb_ + ldst[i]) = (u32x2){SET[i].x, SET[i].y}; *(LAS u32x2*)(nb_ + ldst[i] + 16) = (u32x2){SET[i].z, SET[i].w}; } } } } while (0)
#define AT_COMPUTE(jt) do { \
        LAS unsigned char* kb_ = lds + ((jt) & 1) * STAGE; LAS unsigned char* vb_ = kb_ + KBYTES; \
        f32x16 s0, s1; \
        _Pragma("unroll") for (int i = 0; i < 16; ++i) { s0[i] = 0.f; s1[i] = 0.f; } \
        _Pragma("unroll") for (int s = 0; s < DQ / 16; ++s) { \
            const bf16x8 a0 = *(const LAS bf16x8*)(kb_ + r * KST + s * 32 + hh * 16), a1 = *(const LAS bf16x8*)(kb_ + (32 + r) * KST + s * 32 + hh * 16); \
            s0 = MFMA32(a0, qf[s], s0); s1 = MFMA32(a1, qf[s], s1); } \
        s0 = s0 * sc_log2; s1 = s1 * sc_log2; \
        float mx = fmaxf(s0[0], s1[0]); \
        _Pragma("unroll") for (int i = 1; i < 16; ++i) mx = fmaxf(mx, fmaxf(s0[i], s1[i])); \
        { auto rr_ = __builtin_amdgcn_permlane32_swap(__float_as_uint(mx), __float_as_uint(mx), false, false); mx = fmaxf(__uint_as_float(rr_[0]), __uint_as_float(rr_[1])); } \
        const float mn = fmaxf(m, mx), alpha = __builtin_amdgcn_exp2f(m - mn); \
        m = mn; \
        const f32x2 nmn2 = {-mn, -mn}; f32x2 ps2 = {0.f, 0.f}; \
        _Pragma("unroll") for (int i = 0; i < 8; ++i) { \
            f32x2 ta = {s0[2 * i], s0[2 * i + 1]}, tb = {s1[2 * i], s1[2 * i + 1]}; ta = ta + nmn2; tb = tb + nmn2; \
            ta[0] = __builtin_amdgcn_exp2f(ta[0]); ta[1] = __builtin_amdgcn_exp2f(ta[1]); tb[0] = __builtin_amdgcn_exp2f(tb[0]); tb[1] = __builtin_amdgcn_exp2f(tb[1]); \
            ps2 = ps2 + ta; ps2 = ps2 + tb; s0[2 * i] = ta[0]; s0[2 * i + 1] = ta[1]; s1[2 * i] = tb[0]; s1[2 * i + 1] = tb[1]; } \
        l = l * alpha + (ps2[0] + ps2[1]); \
        if (__builtin_amdgcn_ballot_w64(alpha != 1.0f) != 0ull) { o0 *= alpha; o1 *= alpha; } \
        const bf16x8 p00 = pack8(s0, 0), p01 = pack8(s0, 1), p10 = pack8(s1, 0), p11 = pack8(s1, 1); \
        _Pragma("unroll") for (int dvb = 0; dvb < 2; ++dvb) { \
            LAS unsigned char* vbase = vb_ + (dvb * 32 + r) * VST + hh * 16; \
            f32x16 o = dvb ? o1 : o0; \
            _Pragma("unroll") for (int q = 0; q < 4; ++q) { \
                const bf16x8 v = *(const LAS bf16x8*)(vbase + q * 32); \
                o = MFMA32(v, q == 0 ? p00 : (q == 1 ? p01 : (q == 2 ? p10 : p11)), o); } \
            if (dvb) o1 = o; else o0 = o; } } while (0)
    AT_GLOAD(sA, 0); AT_LSTORE(sA, 0);
    AT_GLOAD(sB, 1); AT_GLOAD(sA, 2);
    lds_barrier();
#pragma unroll 1
    for (int j = 0; j < nt; j += 2) {
        AT_COMPUTE(j);
        AT_LSTORE(sB, j + 1); AT_GLOAD(sB, j + 3);
        lds_barrier();
        AT_COMPUTE(j + 1);
        AT_LSTORE(sA, j + 2); AT_GLOAD(sA, j + 4);
        lds_barrier();
    }
#undef AT_GLOAD
#undef AT_LSTORE
#undef AT_COMPUTE
    AttState st; st.o0 = o0; st.o1 = o1; st.m = m; st.l = l;
    attn_store(st, Ow + (size_t)r * 1024, hh);
}
DI void attn_na_wave(const P& p, int l, int b, int h, int gr, int hf, int lane) {
    const int r = lane & 31, hh = lane >> 5;
    const bf16_t* QC = (const bf16_t*)(p.ws + WS_QC); const bf16_t* KC = (const bf16_t*)(p.ws + WS_KC); const bf16_t* VT = (const bf16_t*)(p.ws + WS_VTC) + (size_t)(b * 4 + h) * 64 * TT;
    const float* rpb = p.in[31] + (size_t)(l * 4 + h) * 15 * 31;
    const int c = hf * 32 + r, tq = CTX + gr * 64 + c; const size_t gq = (size_t)b * TT + tq;
    const float sc_log2 = 0.125f * 1.4426950408889634f;
    bf16x8 qf[4];
#pragma unroll
    for (int s = 0; s < 4; ++s) qf[s] = *(const bf16x8*)(QC + gq * 256 + h * 64 + s * 16 + hh * 8);
    AttState st;
#pragma unroll
    for (int i = 0; i < 16; ++i) { st.o0[i] = 0.f; st.o1[i] = 0.f; }
    st.m = -1e30f; st.l = 0.f;
    const bf16_t* kbase = KC + ((size_t)b * TT + r) * 256 + h * 64 + hh * 8;
    const bf16_t* vp = VT + (size_t)r * TT + 4 * hh;
#pragma unroll 1
    for (int kt = 0; kt < CTX; kt += 32) {
        f32x16 s;
#pragma unroll
        for (int i = 0; i < 16; ++i) s[i] = 0.f;
#pragma unroll
        for (int s2 = 0; s2 < 4; ++s2) s = MFMA32(*(const bf16x8*)(kbase + (size_t)kt * 256 + s2 * 16), qf[s2], s);
#pragma unroll
        for (int i = 0; i < 16; ++i) s[i] *= sc_log2;
        attn_update(st, s, vp + kt);
    }
    int r0 = gr - 4; r0 = r0 < 0 ? 0 : (r0 > 120 ? 120 : r0);
    int c0 = c - 8; c0 = c0 < 0 ? 0 : (c0 > 48 ? 48 : c0);
#pragma unroll 1
    for (int wt = 0; wt < 16; ++wt) {
        const int wi = wt >> 1, ct = wt & 1, key0 = CTX + (r0 + wi) * 64 + ct * 32;
        f32x16 s;
#pragma unroll
        for (int i = 0; i < 16; ++i) s[i] = 0.f;
#pragma unroll
        for (int s2 = 0; s2 < 4; ++s2) s = MFMA32(*(const bf16x8*)(kbase + (size_t)key0 * 256 + s2 * 16), qf[s2], s);
        const float* brow = rpb + (r0 + wi - gr + 7) * 31;
#pragma unroll
        for (int i = 0; i < 16; ++i) {
            const int j = ct * 32 + (i & 3) + 8 * (i >> 2) + 4 * hh;
            const bool ok = (j >= c0) && (j < c0 + 16);
            const int bi = ok ? (j - c + 15) : 0;
            s[i] = ok ? (s[i] * sc_log2 + brow[bi] * 1.4426950408889634f) : -1e30f;
        }
        attn_update(st, s, vp + key0);
    }
    attn_store(st, (bf16_t*)(p.ws + WS_A) + gq * 1024 + 512 + h * 64, hh);
}

constexpr int SCH = 32;
DI int scan_tok(int n, int dir) { return dir == 0 ? n : (n < CTX ? CTX - 1 - n : TT - 1 - (n - CTX)); }
struct FReg { u32x2 r, k, kk, v, e, a; };
DI void fill_load(FReg (&R)[2], const P& p, int b, int h, int dir, int chunk, int lt) {
    const bf16_t* FS = (const bf16_t*)(p.ws + WS_FS); const bf16_t* FD = (const bf16_t*)(p.ws + WS_FD);
    const int ch = (lt & 15) * 4;
#pragma unroll
    for (int i = 0; i < 2; ++i) {
        const int s = (lt >> 4) + 16 * i, t = scan_tok(chunk * SCH + s, dir); const size_t fb = ((size_t)(b * TT + t) * 4 + h) * 256 + ch;
        R[i].r = *(const u32x2*)(FS + fb); R[i].k = *(const u32x2*)(FS + fb + 64); R[i].kk = *(const u32x2*)(FS + fb + 128); R[i].v = *(const u32x2*)(FS + fb + 192);
        R[i].e = *(const u32x2*)(FD + fb + dir * 128); R[i].a = *(const u32x2*)(FD + fb + dir * 128 + 64);
    }
}
constexpr int SST = 400;
DI void fill_store(const FReg (&R)[2], float* buf, int lt, const f32x4 kav) {
    const int ch = (lt & 15) * 4;
#pragma unroll
    for (int i = 0; i < 2; ++i) {
        const int s = (lt >> 4) + 16 * i; float* o = buf + s * SST + ch;
        const f32x4 r = unpack4(R[i].r), k = unpack4(R[i].k), kk = unpack4(R[i].kk), v = unpack4(R[i].v), e = unpack4(R[i].e), a = unpack4(R[i].a);
        f32x4 w;
#pragma unroll
        for (int j = 0; j < 4; ++j) w[j] = __expf(-e[j]);
        const f32x4 ka = kk * a, kd = k * (1.0f + (a - 1.0f) * kav);
        *(f32x4*)(o) = w; *(f32x4*)(o + 64) = kk; *(f32x4*)(o + 128) = -ka; *(f32x4*)(o + 192) = kd; *(f32x4*)(o + 256) = w * r; *(f32x4*)(o + 320) = v;
        const float c1 = red16(kd[0] * r[0] + kd[1] * r[1] + kd[2] * r[2] + kd[3] * r[3]), c2 = red16(ka[0] * r[0] + ka[1] * r[1] + ka[2] * r[2] + ka[3] * r[3]);
        if ((lt & 15) == 0) *(f32x2*)(buf + s * SST + 384) = (f32x2){c1, c2};
    }
}
struct SIn { f32x4 w, kk, nka, kd, wr; float v; f32x2 c; };
DI SIn scan_ld(const float* sb, int c, int row) {
    SIn x; x.w = *(const f32x4*)(sb + 4 * c); x.kk = *(const f32x4*)(sb + 64 + 4 * c); x.nka = *(const f32x4*)(sb + 128 + 4 * c); x.kd = *(const f32x4*)(sb + 192 + 4 * c); x.wr = *(const f32x4*)(sb + 256 + 4 * c);
    x.v = sb[320 + row]; x.c = *(const f32x2*)(sb + 384);
    return x;
}
DI void scan_unit(const P& p, int l, int unit, float* lbuf) {
    const int tid = threadIdx.x + oz(), lane = tid & 63, wave = tid >> 6;
    const int q4 = unit & 3, dir = (unit >> 2) & 1, h = (unit >> 3) & 3, b = unit >> 5;
    float* Y = (float*)(p.ws + (dir ? WS_YB : WS_YF)) + (size_t)b * TT * 256 + h * 64;
    const bool scanner = wave < 4;
    const int c = lane & 15, row = q4 * 16 + (wave & 3) * 4 + (lane >> 4);
    f32x2 Sa = {0.f, 0.f}, Sb = {0.f, 0.f};
    FReg R[2];
    const f32x4 kav = *(const f32x4*)(p.in[25] + l * 256 + h * 64 + (lane & 15) * 4);
    if (!scanner) { fill_load(R, p, b, h, dir, 0, tid - 256); fill_store(R, lbuf, tid - 256, kav); fill_load(R, p, b, h, dir, 1, tid - 256); }
    lds_barrier();
    constexpr int NCH = TT / SCH;
#pragma unroll 1
    for (int ck = 0; ck < NCH; ++ck) {
        float* cur = lbuf + (ck & 1) * (SCH * SST);
        if (!scanner) {
            if (ck + 1 < NCH) fill_store(R, lbuf + ((ck + 1) & 1) * (SCH * SST), tid - 256, kav);
            if (ck + 2 < NCH) fill_load(R, p, b, h, dir, ck + 2, tid - 256);
        }
        else {
            const int n0 = ck * SCH;
            const int tb = dir == 0 ? n0 : ((n0 < CTX ? CTX - 1 : TT + CTX - 1) - n0), sg = dir == 0 ? 1 : -1;
            SIn i0 = scan_ld(cur, c, row), i1 = scan_ld(cur + SST, c, row), i2 = scan_ld(cur + 2 * SST, c, row);
            float ykeep = 0.f;
#pragma unroll
            for (int s = 0; s < SCH; ++s) {
                const SIn x = (s % 3 == 0) ? i0 : ((s % 3 == 1) ? i1 : i2);
                if (s + 3 < SCH) { const SIn nx = scan_ld(cur + (s + 3) * SST, c, row); if (s % 3 == 0) i0 = nx; else if (s % 3 == 1) i1 = nx; else i2 = nx; }
                f32x2 pa = Sa * (f32x2){x.kk[0], x.kk[1]}; pa = Sb * (f32x2){x.kk[2], x.kk[3]} + pa;
                f32x2 pq = Sa * (f32x2){x.wr[0], x.wr[1]}; pq = Sb * (f32x2){x.wr[2], x.wr[3]} + pq;
                float sa = pa[0] + pa[1], yq = pq[0] + pq[1];
                sa = dpp_add<0xB1>(sa); yq = dpp_add<0xB1>(yq); sa = dpp_add<0x4E>(sa); yq = dpp_add<0x4E>(yq);
                sa = dpp_add<0x141>(sa); yq = dpp_add<0x141>(yq); sa = dpp_add<0x140>(sa); yq = dpp_add<0x140>(yq);
                const f32x2 vv = {x.v, x.v}, sv = {sa, sa};
                Sa = Sa * (f32x2){x.w[0], x.w[1]} + vv * (f32x2){x.kd[0], x.kd[1]}; Sb = Sb * (f32x2){x.w[2], x.w[3]} + vv * (f32x2){x.kd[2], x.kd[3]};
                Sa = sv * (f32x2){x.nka[0], x.nka[1]} + Sa; Sb = sv * (f32x2){x.nka[2], x.nka[3]} + Sb;
                const float y = (yq + x.v * x.c[0]) - sa * x.c[1];
                ykeep = (c == (s & 15)) ? y : ykeep;
                if ((s & 15) == 15) { const int t = tb + sg * (s - 15 + c); Y[(size_t)t * 256 + row] = ykeep; }
            }
        }
        lds_barrier();
    }
}
DI void phase_rwkv_out(const P& p, int l) {
    const int tid_ = threadIdx.x + oz(), lane = tid_ & 63, wave = tid_ >> 6, l15 = lane & 15, hd = lane >> 4;
    const float* YF = (const float*)(p.ws + WS_YF); const float* YB = (const float*)(p.ws + WS_YB);
    const bf16_t* FS = (const bf16_t*)(p.ws + WS_FS); const bf16_t* G = (const bf16_t*)(p.ws + WS_G); const float* BON = (const float*)(p.ws + WS_BON);
    bf16_t* O = (bf16_t*)(p.ws + WS_A);
    const f32x4 lg = *(const f32x4*)(p.in[27] + l * 256 + lane * 4), lb = *(const f32x4*)(p.in[28] + l * 256 + lane * 4);
    for (int g0 = (blockIdx.x * 8 + wave) * 2; g0 < MT; g0 += gridDim.x * 16) {
        f32x4 yv[2], vv[2], gv2[2]; float bo[2];
#pragma unroll
        for (int rr = 0; rr < 2; ++rr) { const int g = g0 + rr;
            yv[rr] = *(const f32x4*)(YF + (size_t)g * 256 + lane * 4) + *(const f32x4*)(YB + (size_t)g * 256 + lane * 4);
            vv[rr] = ldbf4(FS + (size_t)g * 1024 + hd * 256 + 192 + l15 * 4); gv2[rr] = ldbf4(G + (size_t)g * 256 + lane * 4); bo[rr] = BON[(size_t)g * 4 + hd]; }
#pragma unroll
        for (int rr = 0; rr < 2; ++rr) { const int g = g0 + rr;
            const f32x4 y = yv[rr];
            const float mu = red16(y[0] + y[1] + y[2] + y[3]) * (1.f / 64);
            const f32x4 d = y - mu;
            const float var = red16(d[0] * d[0] + d[1] * d[1] + d[2] * d[2] + d[3] * d[3]) * (1.f / 64);
            const float rs = rsqrtf(var + 64e-5f);
            const f32x4 o = (d * rs * lg + lb + bo[rr] * vv[rr]) * gv2[rr];
            *(u32x2*)(O + (size_t)g * 1024 + 256 + lane * 4) = pack4(o[0], o[1], o[2], o[3]);
        }
    }
}

constexpr int IT_SCAN = 64, IT_MLA = 2 * 4 * 33, IT_GQA = 2 * 2 * 66, IT_NA = 2 * 4 * 32, IT_NAC = 8;
constexpr int IT_TOTAL = IT_SCAN + IT_MLA + IT_GQA + IT_NA + IT_NAC;
DI void phase_mixers(const P& p, int l, unsigned char* ldsb, unsigned* counter) {
    volatile int* slot = (volatile int*)(ldsb + LDS_MAIN);
    for (;;) {
        const int tid = threadIdx.x + oz(), lane = tid & 63, wave = tid >> 6;
        bf16_t* OM = (bf16_t*)(p.ws + WS_A) + oz();
        __syncthreads();
        if (tid == 0) *slot = (int)atomicAdd(counter, 1u);
        __syncthreads();
        int item = *slot;
        if (item >= IT_TOTAL) break;
        if (item < IT_SCAN) { scan_unit(p, l, item, (float*)ldsb); continue; }
        item -= IT_SCAN;
        if (item < IT_MLA) {
            const int qb = 32 - (item / 8), bh = item % 8, b = bh >> 2, h = bh & 3;
            const int q0 = qb * 256 + wave * 32; const size_t g0 = (size_t)b * TT + q0;
            attn_block<96>((const bf16_t*)(p.ws + WS_QA) + g0 * 384 + h * 96, 384, (const bf16_t*)(p.ws + WS_KA) + (size_t)b * TT * 384 + h * 96, 384,
                           (const bf16_t*)(p.ws + WS_VTA) + (size_t)(b * 4 + h) * 64 * TT, qb == 0 ? CTX : TT, 0.10206207261596577f * 1.4426950408889634f, OM + g0 * 1024 + h * 64, (LAS unsigned char*)ldsb, tid);
            continue;
        }
        item -= IT_MLA;
        if (item < IT_GQA) {
            const int jq = 65 - (item / 4), bk = item % 4, b = bk >> 1, hk = bk & 1, h = hk * 2 + (wave >> 2);
            const int q0 = jq * 128 + (wave & 3) * 32; const size_t g0 = (size_t)b * TT + q0;
            attn_block<64>((const bf16_t*)(p.ws + WS_QD) + g0 * 256 + h * 64, 256, (const bf16_t*)(p.ws + WS_KD) + (size_t)b * TT * 128 + hk * 64, 128,
                           (const bf16_t*)(p.ws + WS_VTD) + (size_t)(b * 2 + hk) * 64 * TT, jq < 2 ? CTX : TT, 0.125f * 1.4426950408889634f, OM + g0 * 1024 + 768 + h * 64, (LAS unsigned char*)ldsb, tid);
            continue;
        }
        item -= IT_GQA;
        if (item < IT_NA) {
            const int bh = item % 8, rb = item / 8, b = bh >> 2, h = bh & 3;
            attn_na_wave(p, l, b, h, rb * 4 + (wave >> 1), wave & 1, lane);
            continue;
        }
        item -= IT_NA;
        {
            const int b = item >> 2, h = item & 3; const size_t g0 = (size_t)b * TT + wave * 32;
            attn_dense_wave<64>((const bf16_t*)(p.ws + WS_QC) + g0 * 256 + h * 64, 256, (const bf16_t*)(p.ws + WS_KC) + (size_t)b * TT * 256 + h * 64, 256,
                                (const bf16_t*)(p.ws + WS_VTC) + (size_t)(b * 4 + h) * 64 * TT, CTX, 0.125f * 1.4426950408889634f, OM + g0 * 1024 + 512 + h * 64, lane);
        }
    }
}

__global__ void __launch_bounds__(512) mega(P p) {
    extern __shared__ __attribute__((aligned(16))) unsigned char lds[];
    cg::grid_group grid = cg::this_grid();
    LAS unsigned char* ldsl = (LAS unsigned char*)lds;
    const int G = gridDim.x, bx = blockIdx.x;
    unsigned* ctl = (unsigned*)(p.ws + WS_CTL);
    XBar XB; XB.bar = ctl; XB.x = xb_xcc_id(); XB.epoch = 0;
    if (threadIdx.x == 0) xb_add(ctl + XB_XCNT(XB.x));

#ifndef NO_PHASE_MOD
{ const f32x4* c4 = (const f32x4*)p.in[2]; f32x4* h4 = (f32x4*)(p.ws + WS_HC); for (size_t i = (size_t)bx * 512 + threadIdx.x; i < (size_t)NB * CTX * DM / 4; i += (size_t)G * 512) h4[i] = c4[i]; }
phase_mod(p, (float*)lds);
#endif


    __syncthreads();

#ifndef NO_PHASE_WEIGHTS
phase_weights(p, 0, 0, (float*)lds);
#endif

    asm volatile("s_waitcnt vmcnt(0)" ::: "memory");
    __syncthreads();
    if (threadIdx.x == 0) {
        __builtin_amdgcn_fence(__ATOMIC_RELEASE, "agent");
        asm volatile("s_waitcnt vmcnt(0)" ::: "memory");
        xb_add(ctl + XB_FLAT);
        while (xb_ld(ctl + XB_FLAT) < (unsigned)G) __builtin_amdgcn_s_sleep(1);
        __builtin_amdgcn_fence(__ATOMIC_ACQUIRE, "agent");
        asm volatile("s_waitcnt vmcnt(0)" ::: "memory");
    }
    __syncthreads();
    if (p.ws == nullptr) grid.sync();
    { unsigned nx = 0; for (int j = 0; j < 16; ++j) nx += xb_ld(ctl + XB_XCNT(j)) != 0u; XB.nx = (unsigned)__builtin_amdgcn_readfirstlane((int)nx); XB.nloc = (unsigned)__builtin_amdgcn_readfirstlane((int)xb_ld(ctl + XB_XCNT(XB.x))); }
#pragma unroll 1
    for (int l = 0; l < 2; ++l) {
#pragma unroll 1
        for (int half = 0; half < 2; ++half) {
            phase_norm(p, l, half * 2, (l == 0 && half == 0) ? 1 : 0, ((l == 0 && half == 0) || (l == 1 && half == 1)) ? 0 : (half == 0 ? 8 : 4));
            if (l == 1 && half == 0) { __syncthreads(); phase_weights(p, 1, 0, (float*)lds); }
            grid_bar(XB);
            {
                pg8::Gemm g; g.A = (const bf16_t*)(p.ws + WS_A); g.Bt = (const bf16_t*)(p.ws + WS_WGU); g.M = MT; g.N = 5632; g.K = 1024; g.lda = 1024;
                pg8::StaticOrder so; so.init(g.M, g.N, g.K, G, bx + oz());
                EpiSwiGLU e; e.hid = (bf16_t*)(p.ws + WS_HID);
                pg8::gemm_phase(ldsl, g, so, e);
            }
            grid_bar(XB);
            {
                pg8::Gemm g; g.A = (const bf16_t*)(p.ws + WS_HID); g.Bt = (const bf16_t*)(p.ws + WS_WD); g.M = MT; g.N = 1024; g.K = DFF; g.lda = DFF;
                pg8::StaticOrder so; so.init(g.M, g.N, g.K, G, bx + oz(), (l == 1 && half == 1) ? 1 : 2, 8);
                EpiResid e; e.gate0 = modp(p, l, 0, half ? 8 : 2); e.hc = (float*)(p.ws + WS_HC); e.out = p.out; e.hc_src = (l == 0 && half == 0) ? p.in[2] : (const float*)(p.ws + WS_HC); e.out_src = (l == 0 && half == 0) ? p.in[0] : (const float*)p.out; e.slab = (float*)(p.ws + WS_SLAB); e.coef = 0.5f; e.skip_ctx = (l == 1 && half == 1);
                pg8::gemm_phase(ldsl, g, so, e);
            }
            grid_bar(XB);
            if (half == 1) break;
            phase_norm(p, l, 1, 0, 8);
            __syncthreads(); phase_weights(p, l, 1, (float*)lds);
            grid_bar(XB);
            {
                pg8::Gemm g; g.A = (const bf16_t*)(p.ws + WS_A); g.Bt = (const bf16_t*)(p.ws + WS_WIN); g.M = MT; g.N = NINP; g.K = 1024; g.lda = 1024;
                pg8::StaticOrder so; so.init(g.M, g.N, g.K, G, bx + oz());
                EpiBf e; e.O = (bf16_t*)(p.ws + WS_U); e.ldo = NINP;
                pg8::gemm_phase(ldsl, g, so, e);
            }
            grid_bar(XB);
            {
                pg8::Gemm g; g.A = (const bf16_t*)(p.ws + WS_U); g.Bt = (const bf16_t*)(p.ws + WS_WMLA); g.M = MT; g.N = 1024; g.K = 384; g.lda = NINP;
                pg8::StaticOrder so; so.init(g.M, g.N, g.K, G, bx + oz());
                EpiBf e; e.O = (bf16_t*)(p.ws + WS_A); e.ldo = 1024;
                pg8::gemm_phase(ldsl, g, so, e);
            }
            __syncthreads();
            phase_prep1(p, l, lds);
            grid_bar(XB);
            phase_prep2(p, l, lds);
            grid_bar(XB);

#ifndef NO_PHASE_MIXERS
phase_mixers(p, l, lds, ctl + l);
#endif

            grid_bar(XB);

#ifndef NO_PHASE_RWKV_OUT
phase_rwkv_out(p, l);
#endif

            grid_bar(XB);
            {
                pg8::Gemm g; g.A = (const bf16_t*)(p.ws + WS_A); g.Bt = (const bf16_t*)(p.ws + WS_WOUT); g.M = MT; g.N = 1024; g.K = 1024; g.lda = 1024;
                pg8::StaticOrder so; so.init(g.M, g.N, g.K, G, bx + oz(), l == 1 ? 1 : 2);
                EpiResid e; e.gate0 = modp(p, l, 0, 5); e.hc = (float*)(p.ws + WS_HC); e.out = p.out; e.hc_src = (const float*)(p.ws + WS_HC); e.out_src = (const float*)p.out; e.slab = (float*)(p.ws + WS_SLAB); e.coef = 1.0f; e.skip_ctx = (l == 1);
                pg8::gemm_phase(ldsl, g, so, e);
            }
            grid_bar(XB);
        }
    }
}

extern "C" void kernel_launch(void* const* d_in, const int* in_sizes, int n_in,
                              void* d_out, int out_size, void* d_ws, size_t ws_size,
                              hipStream_t stream) {
    static int grid_blocks = 0;
    if (!grid_blocks) {
        int dev = 0, cus = 0, per_cu = 0;
        (void)hipGetDevice(&dev);
        (void)hipDeviceGetAttribute(&cus, hipDeviceAttributeMultiprocessorCount, dev);
        (void)hipFuncSetAttribute((const void*)mega, hipFuncAttributeMaxDynamicSharedMemorySize, LDS_BYTES);
        (void)hipOccupancyMaxActiveBlocksPerMultiprocessor(&per_cu, (const void*)mega, 512, LDS_BYTES);
        if (per_cu < 1) per_cu = 1;
        grid_blocks = cus * per_cu;
        if (ws_size < WS_END2) fprintf(stderr, "workspace too small: %zu < %zu\n", ws_size, (size_t)WS_END2);
    }
    P p{};
    for (int i = 0; i < 37; ++i) p.in[i] = (const float*)d_in[i];
    p.out = (float*)d_out; p.ws = (unsigned char*)d_ws;
    (void)hipMemsetAsync((char*)d_ws + WS_CTL, 0, 16384, stream);
    void* args[] = {&p};
    hipError_t e = hipLaunchCooperativeKernel((void*)mega, dim3(grid_blocks), dim3(512), args, LDS_BYTES, stream);
    if (e != hipSuccess) fprintf(stderr, "cooperative launch failed: %s (grid %d)\n", hipGetErrorString(e), grid_blocks);
}
```
